# Optimizing an MI355X kernel written in HIP

```python
import jax, jax.numpy as jnp
from jax import lax
import numpy as np

D_MODEL = 2048
BATCH = 4
SEQ = 4096
DEPTH = 2

MLA_HEADS = 16
MLA_NOPE = 128
MLA_ROPE = 64
MLA_QK = MLA_NOPE + MLA_ROPE
MLA_V = 128
Q_LORA = 512
KV_LORA = 512
ROPE_THETA = 10000.0
SB_HEADS = 16
SB_DIM = 64
FOX_HEADS = 16
FOX_DIM = 64
BLOCK_Q = 128
N_BRANCH = 3
EPS = 1e-6
N_GROUPS = 8
EXPERTS_PER_GROUP = 8
N_EXPERTS = N_GROUPS * EXPERTS_PER_GROUP
TOP_K = 2
D_EXPERT = 512
MOE_BLOCK = 128
D_IN = (Q_LORA + KV_LORA + MLA_ROPE + 3 * SB_HEADS * SB_DIM + 3 * FOX_HEADS * FOX_DIM
        + FOX_HEADS + N_BRANCH * D_MODEL)

kernel_name = "hybrid_mla_stickbreak_fox_hmoe"


def _segment_offsets():
    segs = (("mla_cq", Q_LORA), ("mla_ckv", KV_LORA), ("mla_krope", MLA_ROPE),
            ("sb_q", SB_HEADS * SB_DIM), ("sb_k", SB_HEADS * SB_DIM), ("sb_v", SB_HEADS * SB_DIM),
            ("fox_q", FOX_HEADS * FOX_DIM), ("fox_k", FOX_HEADS * FOX_DIM), ("fox_v", FOX_HEADS * FOX_DIM),
            ("fox_f", FOX_HEADS), ("gates", N_BRANCH * D_MODEL))
    off, start = {}, 0
    for name, width in segs:
        off[name] = (start, start + width)
        start += width
    return off


def _proj(xn, w_in_l, off, name):
    a, b = off[name]
    return xn @ w_in_l[:, a:b]


def _rms(x, g):
    xf = x.astype(jnp.float32)
    y = xf * lax.rsqrt(jnp.mean(xf * xf, axis=-1, keepdims=True) + EPS)
    return (y * g.astype(jnp.float32)).astype(x.dtype)


def _rope_tables(positions):
    inv_freq = ROPE_THETA ** (-jnp.arange(0, MLA_ROPE, 2, dtype=jnp.float32) / MLA_ROPE)
    ang = positions.astype(jnp.float32)[..., None] * inv_freq
    return jnp.cos(ang), jnp.sin(ang)


def _rope(x, cos, sin):
    half = x.shape[-1] // 2
    xf = x.astype(jnp.float32)
    x1, x2 = xf[..., :half], xf[..., half:]
    return jnp.concatenate([x1 * cos - x2 * sin, x2 * cos + x1 * sin], axis=-1).astype(x.dtype)


def _softmax_attention(q, k, v, scale, log_decay=None):
    S = q.shape[1]
    outs = []
    for i in range(S // BLOCK_Q):
        lo, hi = i * BLOCK_Q, (i + 1) * BLOCK_Q
        s = jnp.einsum("bqhd,bkhd->bhqk", q[:, lo:hi], k[:, :hi]).astype(jnp.float32) * scale
        if log_decay is not None:
            s = s + (log_decay[:, :, lo:hi, None] - log_decay[:, :, None, :hi])
        mask = (lo + jnp.arange(BLOCK_Q))[:, None] >= jnp.arange(hi)[None, :]
        p = jax.nn.softmax(jnp.where(mask, s, -jnp.inf), axis=-1)
        outs.append(jnp.einsum("bhqk,bkhd->bqhd", p.astype(v.dtype), v[:, :hi]))
    return jnp.concatenate(outs, axis=1)


def _stick_breaking_attention(q, k, v, scale):
    S = q.shape[1]
    outs = []
    for i in range(S // BLOCK_Q):
        lo, hi = i * BLOCK_Q, (i + 1) * BLOCK_Q
        z = jnp.einsum("bqhd,bkhd->bhqk", q[:, lo:hi], k[:, :hi]).astype(jnp.float32) * scale
        strict = (lo + jnp.arange(BLOCK_Q))[:, None] > jnp.arange(hi)[None, :]
        log_keep = jnp.where(strict, jax.nn.log_sigmoid(-z), 0.0)
        suffix = lax.cumsum(log_keep, axis=3, reverse=True) - log_keep
        w = jnp.where(strict, jnp.exp(jax.nn.log_sigmoid(z) + suffix), 0.0)
        outs.append(jnp.einsum("bhqk,bkhd->bqhd", w.astype(v.dtype), v[:, :hi]))
    return jnp.concatenate(outs, axis=1)


def _mla_branch(xn, w_in_l, off, g_cq, w_uq, g_ckv, w_ukv, g_q, g_k, cos, sin):
    B, S, _ = xn.shape
    c_q = _rms(_proj(xn, w_in_l, off, "mla_cq"), g_cq)
    q = (c_q @ w_uq).reshape(B, S, MLA_HEADS, MLA_QK)
    c_kv = _rms(_proj(xn, w_in_l, off, "mla_ckv"), g_ckv)
    kv = (c_kv @ w_ukv).reshape(B, S, MLA_HEADS, MLA_NOPE + MLA_V)
    k_nope, v = kv[..., :MLA_NOPE], kv[..., MLA_NOPE:]
    k_rope = _proj(xn, w_in_l, off, "mla_krope")
    k_rope = jnp.broadcast_to(k_rope[:, :, None, :], (B, S, MLA_HEADS, MLA_ROPE))
    k = jnp.concatenate([k_nope, k_rope], axis=-1)
    q, k = _rms(q, g_q), _rms(k, g_k)
    c, s = cos[:, :, None, :], sin[:, :, None, :]
    q = jnp.concatenate([q[..., :MLA_NOPE], _rope(q[..., MLA_NOPE:], c, s)], axis=-1)
    k = jnp.concatenate([k[..., :MLA_NOPE], _rope(k[..., MLA_NOPE:], c, s)], axis=-1)
    o = _softmax_attention(q, k, v, MLA_QK ** -0.5)
    return o.reshape(B, S, MLA_HEADS * MLA_V)


def _sb_branch(xn, w_in_l, off, g_q, g_k):
    B, S, _ = xn.shape
    shp = (B, S, SB_HEADS, SB_DIM)
    q = _rms(_proj(xn, w_in_l, off, "sb_q").reshape(shp), g_q)
    k = _rms(_proj(xn, w_in_l, off, "sb_k").reshape(shp), g_k)
    v = _proj(xn, w_in_l, off, "sb_v").reshape(shp)
    o = _stick_breaking_attention(q, k, v, SB_DIM ** -0.5)
    return o.reshape(B, S, SB_HEADS * SB_DIM)


def _fox_branch(xn, w_in_l, off, g_q, g_k, f_bias):
    B, S, _ = xn.shape
    shp = (B, S, FOX_HEADS, FOX_DIM)
    q = _rms(_proj(xn, w_in_l, off, "fox_q").reshape(shp), g_q)
    k = _rms(_proj(xn, w_in_l, off, "fox_k").reshape(shp), g_k)
    v = _proj(xn, w_in_l, off, "fox_v").reshape(shp)
    f_logit = _proj(xn, w_in_l, off, "fox_f").astype(jnp.float32) + f_bias.astype(jnp.float32)
    cum_log_f = jnp.cumsum(jax.nn.log_sigmoid(f_logit), axis=1)
    o = _softmax_attention(q, k, v, FOX_DIM ** -0.5, jnp.transpose(cum_log_f, (0, 2, 1)))
    return o.reshape(B, S, FOX_HEADS * FOX_DIM)


def _hier_moe(h, w_group, w_router, w_gate, w_up, w_down):
    N, D = h.shape
    rows = jnp.arange(N)
    g_logits = (h @ w_group).astype(jnp.float32)
    g_prob = jax.nn.softmax(g_logits, axis=-1)
    g_idx = jnp.argmax(g_logits, axis=-1)
    p_group = g_prob[rows, g_idx]
    e_logits = (h @ w_router).astype(jnp.float32).reshape(N, N_GROUPS, EXPERTS_PER_GROUP)
    e_in = e_logits[rows, g_idx]
    top_v, top_i = lax.top_k(e_in, TOP_K)
    gate = p_group[:, None] * jax.nn.softmax(top_v, axis=-1)
    expert = g_idx[:, None] * EXPERTS_PER_GROUP + top_i
    A = N * TOP_K
    e_flat = expert.reshape(-1)
    tok_flat = jnp.repeat(rows, TOP_K)
    order = jnp.argsort(e_flat)
    e_s, tok_s, w_s = e_flat[order], tok_flat[order], gate.reshape(-1)[order]
    counts = jnp.bincount(e_flat, length=N_EXPERTS)
    starts = jnp.cumsum(counts) - counts
    padded = ((counts + MOE_BLOCK - 1) // MOE_BLOCK) * MOE_BLOCK
    pad_ends = jnp.cumsum(padded)
    pad_starts = pad_ends - padded
    dest = pad_starts[e_s] + (jnp.arange(A) - starts[e_s])
    n_blocks = (A + N_EXPERTS * (MOE_BLOCK - 1)) // MOE_BLOCK + 1
    P = n_blocks * MOE_BLOCK
    buf_tok = jnp.zeros((P,), jnp.int32).at[dest].set(tok_s.astype(jnp.int32))
    buf_w = jnp.zeros((P,), h.dtype).at[dest].set(w_s.astype(h.dtype))
    block_e = jnp.minimum(
        jnp.searchsorted(pad_ends, jnp.arange(n_blocks) * MOE_BLOCK, side="right"), N_EXPERTS - 1)

    def expert_block(args):
        tok, e = args
        xb = h[tok]
        return (jax.nn.silu(xb @ w_gate[e]) * (xb @ w_up[e])) @ w_down[e]

    y = lax.map(expert_block, (buf_tok.reshape(n_blocks, MOE_BLOCK), block_e))
    y = y.reshape(P, D) * buf_w[:, None]
    return jnp.zeros((N, D), h.dtype).at[buf_tok].add(y)


def setup_inputs(seed: int = 0) -> dict:
    key = jax.random.key(seed)
    k = jax.random.split(key, 32)
    f32 = jnp.float32
    L = DEPTH

    def nrm(i, shape, fan_in):
        return jax.random.normal(k[i], shape, f32) * (fan_in ** -0.5)

    def gain(i, shape):
        return 1.0 + 0.02 * jax.random.normal(k[i], shape, f32)

    x = jax.random.normal(k[0], (BATCH, SEQ, D_MODEL), f32)
    offs = jax.random.randint(k[1], (BATCH, 1), 0, 1024, dtype=jnp.int32)
    positions = (offs + jnp.arange(SEQ, dtype=jnp.int32)[None, :]).astype(jnp.int32)
    return {
        "x": x,
        "positions": positions,
        "norm_mix": gain(2, (L, D_MODEL)),
        "w_in": nrm(3, (L, D_MODEL, D_IN), D_MODEL),
        "mla_cq_norm": gain(4, (L, Q_LORA)),
        "mla_w_uq": nrm(5, (L, Q_LORA, MLA_HEADS * MLA_QK), Q_LORA),
        "mla_ckv_norm": gain(6, (L, KV_LORA)),
        "mla_w_ukv": nrm(7, (L, KV_LORA, MLA_HEADS * (MLA_NOPE + MLA_V)), KV_LORA),
        "mla_q_norm": gain(8, (L, MLA_QK)),
        "mla_k_norm": gain(9, (L, MLA_QK)),
        "sb_q_norm": gain(10, (L, SB_DIM)),
        "sb_k_norm": gain(11, (L, SB_DIM)),
        "fox_q_norm": gain(12, (L, FOX_DIM)),
        "fox_k_norm": gain(13, (L, FOX_DIM)),
        "fox_f_bias": 3.0 + 0.5 * jax.random.normal(k[14], (L, FOX_HEADS), f32),
        "w_branch_mla": nrm(15, (L, MLA_HEADS * MLA_V, D_MODEL), MLA_HEADS * MLA_V),
        "w_branch_sb": nrm(16, (L, SB_HEADS * SB_DIM, D_MODEL), SB_HEADS * SB_DIM),
        "w_branch_fox": nrm(17, (L, FOX_HEADS * FOX_DIM, D_MODEL), FOX_HEADS * FOX_DIM),
        "w_out": nrm(18, (L, D_MODEL, D_MODEL), D_MODEL),
        "norm_ffn": gain(19, (L, D_MODEL)),
        "w_group": nrm(20, (L, D_MODEL, N_GROUPS), D_MODEL),
        "w_router": nrm(21, (L, D_MODEL, N_EXPERTS), D_MODEL),
        "w_e_gate": nrm(22, (L, N_EXPERTS, D_MODEL, D_EXPERT), D_MODEL),
        "w_e_up": nrm(23, (L, N_EXPERTS, D_MODEL, D_EXPERT), D_MODEL),
        "w_e_down": nrm(24, (L, N_EXPERTS, D_EXPERT, D_MODEL), D_EXPERT),
    }


def reference(x, positions, norm_mix, w_in, mla_cq_norm, mla_w_uq, mla_ckv_norm, mla_w_ukv,
              mla_q_norm, mla_k_norm, sb_q_norm, sb_k_norm, fox_q_norm, fox_k_norm, fox_f_bias,
              w_branch_mla, w_branch_sb, w_branch_fox, w_out, norm_ffn, w_group, w_router,
              w_e_gate, w_e_up, w_e_down):
    B, S, D = x.shape
    cos, sin = _rope_tables(positions)
    off = _segment_offsets()
    for l in range(DEPTH):
        xn = _rms(x, norm_mix[l])
        w_in_l = w_in[l]
        o_a = _mla_branch(xn, w_in_l, off, mla_cq_norm[l], mla_w_uq[l], mla_ckv_norm[l],
                          mla_w_ukv[l], mla_q_norm[l], mla_k_norm[l], cos, sin)
        o_b = _sb_branch(xn, w_in_l, off, sb_q_norm[l], sb_k_norm[l])
        o_c = _fox_branch(xn, w_in_l, off, fox_q_norm[l], fox_k_norm[l], fox_f_bias[l])
        gates = jax.nn.sigmoid(_proj(xn, w_in_l, off, "gates").astype(jnp.float32))
        gates = gates.reshape(B, S, N_BRANCH, D).astype(x.dtype)
        merged = (gates[:, :, 0] * (o_a @ w_branch_mla[l])
                  + gates[:, :, 1] * (o_b @ w_branch_sb[l])
                  + gates[:, :, 2] * (o_c @ w_branch_fox[l]))
        x = x + merged @ w_out[l]
        h = _rms(x, norm_ffn[l]).reshape(B * S, D)
        x = x + _hier_moe(h, w_group[l], w_router[l], w_e_gate[l], w_e_up[l], w_e_down[l]).reshape(B, S, D)
    return x
```

```cpp
#include <hip/hip_runtime.h>
#include <cstdio>
#include <cstdint>
#include <cmath>
namespace pg8 {
#define PG8_LAS __attribute__((address_space(3)))
typedef unsigned short bf16_t;
typedef short bf16x8 __attribute__((ext_vector_type(8)));
typedef float f32x4 __attribute__((ext_vector_type(4)));
typedef unsigned u32x4 __attribute__((ext_vector_type(4)));
constexpr int BM = 256, BK = 64, HALF = 128, HTB = HALF * BK * 2  , STAGE_BYTES = 8 * HTB, NXCD = 8, WGM = 4;

__host__ __device__ __forceinline__ int lds_byte(int r, int c) { const int st = (r >> 4) * 2 + (c >> 5), rr = r & 15, cc = c & 31, ob = rr * 64 + cc * 2; return st * 1024 + (ob ^ (((ob >> 9) & 1) << 5)); }
__host__ __device__ __forceinline__ void stage_rc(int b, int& R, int& C) { const int st = b / 1024, sb = b % 1024, swz = sb ^ (((sb >> 9) & 1) << 5); R = (st >> 1) * 16 + swz / 64; C = (st & 1) * 32 + (swz % 64) / 2; }
__host__ __device__ __forceinline__ int perm32(int rho) { const int n = rho >> 4, i = rho & 15; return 8 * (i >> 2) + 4 * n + (i & 3); }

struct Unit { int pm, pn; };
struct Gemm { const bf16_t* A; const bf16_t* Bt; int M, N, K; };

struct StaticOrder {
    int nM, nN, nwg, G, c, wgm;
    __host__ __device__ void init(int M, int N, int G_, int c_, int wgm_ = WGM) { nM = M / BM; nN = N / BM; nwg = nM * nN; G = G_; c = c_; wgm = wgm_; }
    __host__ __device__ bool next(int i, Unit& u) const {
        const long L = (long)i * G + c; if (L >= nwg) return false;
        int wgid = (int)L; { const int q = nwg / NXCD, r = nwg % NXCD, xcd = wgid % NXCD, off = wgid / NXCD; wgid = (xcd < r ? xcd * (q + 1) : r * (q + 1) + (xcd - r) * q) + off; }
        const int nig = wgm * nN, gid = wgid / nig, fm = gid * wgm, gsz = (nM - fm) < wgm ? (nM - fm) : wgm;
        u.pm = fm + ((wgid % nig) % gsz); u.pn = (wgid % nig) / gsz; return true;
    }
    __device__ __forceinline__ void a_ready(const Unit&) const {}
    __device__ __forceinline__ void done(const Unit&) const {}
};
__device__ __forceinline__ unsigned cvt_pk_bf16(float lo, float hi) { unsigned r; asm volatile("v_cvt_pk_bf16_f32 %0, %1, %2" : "=v"(r) : "v"(lo), "v"(hi)); return r; }
typedef float f32x2 __attribute__((ext_vector_type(2)));
typedef unsigned u32x2 __attribute__((ext_vector_type(2)));
__device__ __forceinline__ float bf2f(unsigned short b) { return __uint_as_float(((unsigned)b) << 16); }
__device__ __forceinline__ float bperm_xor(float v, int mask, int lane) { return __int_as_float(__builtin_amdgcn_ds_bpermute((lane ^ mask) << 2, __float_as_int(v))); }
__device__ __forceinline__ float sigmoidf_fast(float x) { return __builtin_amdgcn_rcpf(1.0f + __builtin_amdgcn_exp2f(-1.4426950408889634f * x)); }

struct EpiSeg {
    static constexpr bool PERM = true, AFTER_DRAIN = false;
    unsigned char* ws; const float* gn;
    static constexpr size_t O_CQ = 536ull << 20, O_CKV = 552ull << 20, O_QKV6 = 568ull << 20, O_GATES = 760ull << 20, O_PART = (1ull << 20) + 65536, O_RS = (1ull << 20) + 655360, SEG_BYTES = 16384ull * 1024 * 2;
    __device__ __forceinline__ void operator()(const f32x4 (&acc)[2][2][4][2], const Unit& u, int wr, int wc, int fr, int fq) const {
        const int pn = u.pn; bf16_t* base; int ldc, colt, kind = 0, gsel = 0;
        if (pn < 2) { base = (bf16_t*)(ws + O_CQ); ldc = 512; colt = 256 * pn; }
        else if (pn < 4) { base = (bf16_t*)(ws + O_CKV); ldc = 512; colt = 256 * (pn - 2); kind = 1; }
        else if (pn < 28) { const int s = (pn - 4) >> 2; base = (bf16_t*)(ws + O_QKV6 + (size_t)s * SEG_BYTES); ldc = 1024; colt = 256 * ((pn - 4) & 3);
            if (s != 2 && s != 5) { kind = 2; gsel = (s & 1) + (s >= 3 ? 2 : 0); } }
        else { base = (bf16_t*)(ws + O_GATES); ldc = 6144; colt = 256 * (pn - 28); }
        const int row0 = u.pm * BM + wr * 64 + fr;
        if (kind != 2) {
            const int col0 = colt + wc * 32 + 8 * fq;
#pragma unroll
            for (int ai = 0; ai < 2; ++ai) {
                float rs[4];
#pragma unroll
                for (int m = 0; m < 4; ++m) rs[m] = ((const float*)(ws + O_RS))[row0 + ai * HALF + m * 16];
                __builtin_amdgcn_sched_barrier(0);
#pragma unroll
                for (int m = 0; m < 4; ++m) { bf16_t* rowp = base + (size_t)(row0 + ai * HALF + m * 16) * ldc + col0;
#pragma unroll
                    for (int bj = 0; bj < 2; ++bj) { const f32x4 v0 = acc[ai][bj][m][0] * rs[m], v1 = acc[ai][bj][m][1] * rs[m];
                        u32x4 w; w.x = cvt_pk_bf16(v0[0], v0[1]); w.y = cvt_pk_bf16(v0[2], v0[3]); w.z = cvt_pk_bf16(v1[0], v1[1]); w.w = cvt_pk_bf16(v1[2], v1[3]);
                        *(u32x4*)(rowp + bj * HALF) = w; } }
                if (kind == 1) {
                    float* part = (float*)(ws + O_PART);
#pragma unroll
                    for (int m = 0; m < 4; ++m) { float s = 0.f;
#pragma unroll
                        for (int bj = 0; bj < 2; ++bj)
#pragma unroll
                            for (int n = 0; n < 2; ++n) { const f32x4 x = acc[ai][bj][m][n] * rs[m]; s += (x[0] * x[0] + x[1] * x[1]) + (x[2] * x[2] + x[3] * x[3]); }
                        { const int ln_ = fr | (fq << 4); s += bperm_xor(s, 16, ln_); s += bperm_xor(s, 32, ln_); }
                        if (fq == 0) part[(size_t)(row0 + ai * HALF + m * 16) * 8 + (pn - 2) * 4 + wc] = s; } }
                __builtin_amdgcn_sched_barrier(0); }
        } else {
            const float* g = gn + gsel * 64 + 8 * fq; const f32x4 ga0 = *(const f32x4*)g, ga1 = *(const f32x4*)(g + 4), gb0 = *(const f32x4*)(g + 32), gb1 = *(const f32x4*)(g + 36);
            const float qs = (gsel & 1) ? 1.0f : 0.125f * 1.4426950408889634f;
            const int col0 = colt + wc * 64 + 8 * fq;
#pragma unroll
            for (int ai = 0; ai < 2; ++ai)
#pragma unroll
                for (int m = 0; m < 4; ++m) { float s = 0.f;
#pragma unroll
                    for (int bj = 0; bj < 2; ++bj)
#pragma unroll
                        for (int n = 0; n < 2; ++n) { const f32x4 x = acc[ai][bj][m][n]; s += (x[0] * x[0] + x[1] * x[1]) + (x[2] * x[2] + x[3] * x[3]); }
                    { const int ln_ = fr | (fq << 4); s += bperm_xor(s, 16, ln_); s += bperm_xor(s, 32, ln_); }
                    const float r = qs * __builtin_amdgcn_rsqf(s * (1.0f / 64.f) + 1e-6f);
                    bf16_t* rowp = base + (size_t)(row0 + ai * HALF + m * 16) * ldc + col0;
                    { const f32x4 v0 = acc[ai][0][m][0] * ga0 * r, v1 = acc[ai][0][m][1] * ga1 * r;
                      u32x4 w; w.x = cvt_pk_bf16(v0[0], v0[1]); w.y = cvt_pk_bf16(v0[2], v0[3]); w.z = cvt_pk_bf16(v1[0], v1[1]); w.w = cvt_pk_bf16(v1[2], v1[3]); *(u32x4*)rowp = w; }
                    { const f32x4 v0 = acc[ai][1][m][0] * gb0 * r, v1 = acc[ai][1][m][1] * gb1 * r;
                      u32x4 w; w.x = cvt_pk_bf16(v0[0], v0[1]); w.y = cvt_pk_bf16(v0[2], v0[3]); w.z = cvt_pk_bf16(v1[0], v1[1]); w.w = cvt_pk_bf16(v1[2], v1[3]); *(u32x4*)(rowp + 32) = w; } }
        }
    }
};
struct EpiPlain {
    static constexpr bool PERM = true, AFTER_DRAIN = false;
    bf16_t* O; int ldc;
    __device__ __forceinline__ void operator()(const f32x4 (&acc)[2][2][4][2], const Unit& u, int wr, int wc, int fr, int fq) const {
        const int row0 = u.pm * BM + wr * 64 + fr, col0 = u.pn * BM + wc * 32 + 8 * fq;
#pragma unroll
        for (int ai = 0; ai < 2; ++ai)
#pragma unroll
            for (int m = 0; m < 4; ++m) { bf16_t* rowp = O + (size_t)(row0 + ai * HALF + m * 16) * ldc + col0;
#pragma unroll
                for (int bj = 0; bj < 2; ++bj) { const f32x4 v0 = acc[ai][bj][m][0], v1 = acc[ai][bj][m][1];
                    u32x4 w; w.x = cvt_pk_bf16(v0[0], v0[1]); w.y = cvt_pk_bf16(v0[2], v0[3]); w.z = cvt_pk_bf16(v1[0], v1[1]); w.w = cvt_pk_bf16(v1[2], v1[3]);
                    *(u32x4*)(rowp + bj * HALF) = w; } }
    }
};
struct EpiKV {
    static constexpr bool PERM = true, AFTER_DRAIN = false;
    bf16_t* KN; bf16_t* V; const float* part;
    __device__ __forceinline__ void operator()(const f32x4 (&acc)[2][2][4][2], const Unit& u, int wr, int wc, int fr, int fq) const {
        const int row0 = u.pm * BM + wr * 64 + fr, col0 = u.pn * 128 + wc * 32 + 8 * fq;
        f32x4 pav[2][4], pbv[2][4];
#pragma unroll
        for (int ai = 0; ai < 2; ++ai)
#pragma unroll
            for (int m = 0; m < 4; ++m) { const int rw = row0 + ai * HALF + m * 16; pav[ai][m] = *(const f32x4*)(part + (size_t)rw * 8); pbv[ai][m] = *(const f32x4*)(part + (size_t)rw * 8 + 4); }
        __builtin_amdgcn_sched_barrier(0);
#pragma unroll
        for (int ai = 0; ai < 2; ++ai)
#pragma unroll
            for (int m = 0; m < 4; ++m) { const int rw = row0 + ai * HALF + m * 16; const size_t off = (size_t)rw * 2048 + col0;
                const f32x4 pa = pav[ai][m], pb = pbv[ai][m];
                const float ssq = ((pa[0] + pa[1]) + (pa[2] + pa[3])) + ((pb[0] + pb[1]) + (pb[2] + pb[3]));
                const float r = __builtin_amdgcn_rsqf(ssq * (1.0f / 512.f) + 1e-6f);
#pragma unroll
                for (int bj = 0; bj < 2; ++bj) { const f32x4 v0 = acc[ai][bj][m][0] * r, v1 = acc[ai][bj][m][1] * r;
                    u32x4 w; w.x = cvt_pk_bf16(v0[0], v0[1]); w.y = cvt_pk_bf16(v0[2], v0[3]); w.z = cvt_pk_bf16(v1[0], v1[1]); w.w = cvt_pk_bf16(v1[2], v1[3]);
                    *(u32x4*)((bj == 0 ? KN : V) + off) = w; } }
    }
};
struct EpiKF {
    static constexpr bool PERM = true, AFTER_DRAIN = false;
    bf16_t* K; bf16_t* V; const float* part; const float* ssr; const float* kr; const float* gk; unsigned xch;
    __device__ __forceinline__ void operator()(const f32x4 (&acc)[2][2][4][2], const Unit& u, int wr, int wc, int fr, int fq) const {
        const int row0 = u.pm * BM + wr * 64 + fr, lane = fq * 16 + fr;
        PG8_LAS float* X = (PG8_LAS float*)(size_t)xch;
        float rc[2][4];
        { f32x4 pav[2][4], pbv[2][4];
#pragma unroll
          for (int ai = 0; ai < 2; ++ai)
#pragma unroll
            for (int m = 0; m < 4; ++m) { const int rw = row0 + ai * HALF + m * 16; pav[ai][m] = *(const f32x4*)(part + (size_t)rw * 8); pbv[ai][m] = *(const f32x4*)(part + (size_t)rw * 8 + 4); }
          __builtin_amdgcn_sched_barrier(0);
#pragma unroll
          for (int ai = 0; ai < 2; ++ai)
#pragma unroll
            for (int m = 0; m < 4; ++m) { const f32x4 pa = pav[ai][m], pb = pbv[ai][m];
                const float r = __builtin_amdgcn_rsqf((((pa[0] + pa[1]) + (pa[2] + pa[3])) + ((pb[0] + pb[1]) + (pb[2] + pb[3]))) * (1.0f / 512.f) + 1e-6f); rc[ai][m] = r;
                const f32x4 v0 = acc[ai][0][m][0] * r, v1 = acc[ai][0][m][1] * r;
                float s = ((v0[0] * v0[0] + v0[1] * v0[1]) + (v0[2] * v0[2] + v0[3] * v0[3])) + ((v1[0] * v1[0] + v1[1] * v1[1]) + (v1[2] * v1[2] + v1[3] * v1[3]));
                s += bperm_xor(s, 16, lane); s += bperm_xor(s, 32, lane);
                if (fq == 0) X[(ai * HALF + wr * 64 + m * 16 + fr) * 4 + wc] = s; } }
        const f32x4 g0 = *(const f32x4*)(gk + wc * 32 + 8 * fq), g1 = *(const f32x4*)(gk + wc * 32 + 8 * fq + 4);
        float sr[2][4]; f32x4 kq[2][4];
#pragma unroll
        for (int ai = 0; ai < 2; ++ai)
#pragma unroll
            for (int m = 0; m < 4; ++m) { const int rw = row0 + ai * HALF + m * 16; sr[ai][m] = ssr[rw]; kq[ai][m] = *(const f32x4*)(kr + (size_t)rw * 80 + 16 * wc + 4 * fq); }
        __builtin_amdgcn_sched_barrier(0);
        asm volatile("s_waitcnt lgkmcnt(0)" ::: "memory"); __builtin_amdgcn_s_barrier();
#pragma unroll
        for (int ai = 0; ai < 2; ++ai)
#pragma unroll
            for (int m = 0; m < 4; ++m) { const int rw = row0 + ai * HALF + m * 16; const float r = rc[ai][m];
                const f32x4 p = *(const PG8_LAS f32x4*)(X + (ai * HALF + wr * 64 + m * 16 + fr) * 4);
                const float rn = __builtin_amdgcn_rsqf((((p[0] + p[1]) + (p[2] + p[3])) + sr[ai][m]) * (1.0f / 192.f) + 1e-6f), rk = r * rn;
                { const f32x4 v0 = acc[ai][0][m][0] * rk * g0, v1 = acc[ai][0][m][1] * rk * g1;
                  u32x4 w; w.x = cvt_pk_bf16(v0[0], v0[1]); w.y = cvt_pk_bf16(v0[2], v0[3]); w.z = cvt_pk_bf16(v1[0], v1[1]); w.w = cvt_pk_bf16(v1[2], v1[3]);
                  *(u32x4*)(K + (size_t)rw * 3072 + u.pn * 192 + wc * 32 + 8 * fq) = w; }
                { const f32x4 v0 = acc[ai][1][m][0] * r, v1 = acc[ai][1][m][1] * r;
                  u32x4 w; w.x = cvt_pk_bf16(v0[0], v0[1]); w.y = cvt_pk_bf16(v0[2], v0[3]); w.z = cvt_pk_bf16(v1[0], v1[1]); w.w = cvt_pk_bf16(v1[2], v1[3]);
                  *(u32x4*)(V + (size_t)rw * 2048 + u.pn * 128 + wc * 32 + 8 * fq) = w; }
                { const f32x4 q = kq[ai][m] * rn;
                  u32x2 w; w.x = cvt_pk_bf16(q[0], q[1]); w.y = cvt_pk_bf16(q[2], q[3]);
                  *(u32x2*)(K + (size_t)rw * 3072 + u.pn * 192 + 128 + 16 * wc + 4 * fq) = w; } }
    }
};
template <int MODE> struct EpiMerge {
    static constexpr bool PERM = true, AFTER_DRAIN = false;
    const bf16_t* gate; bf16_t* Mb;
    __device__ __forceinline__ void operator()(const f32x4 (&acc)[2][2][4][2], const Unit& u, int wr, int wc, int fr, int fq) const {
        const int row0 = u.pm * BM + wr * 64 + fr, col0 = u.pn * BM + wc * 32 + 8 * fq;
#pragma unroll
        for (int ai = 0; ai < 2; ++ai) {
            u32x4 gw[4][2], mw[4][2];
#pragma unroll
            for (int m = 0; m < 4; ++m)
#pragma unroll
                for (int bj = 0; bj < 2; ++bj) { const size_t r = (size_t)(row0 + ai * HALF + m * 16); const int c = col0 + bj * HALF;
                    gw[m][bj] = __builtin_nontemporal_load((const u32x4*)(gate + r * 6144 + c)); if (MODE >= 1)     mw[m][bj] = *(const u32x4*)(Mb + r * 2048 + c); }
            __builtin_amdgcn_sched_barrier(0);
#pragma unroll
            for (int m = 0; m < 4; ++m)
#pragma unroll
                for (int bj = 0; bj < 2; ++bj) { const size_t r = (size_t)(row0 + ai * HALF + m * 16); const int c = col0 + bj * HALF; const u32x4 g_ = gw[m][bj];
                    f32x4 g0, g1; g0[0] = sigmoidf_fast(__uint_as_float(g_.x << 16)); g0[1] = sigmoidf_fast(__uint_as_float(g_.x & 0xffff0000u)); g0[2] = sigmoidf_fast(__uint_as_float(g_.y << 16)); g0[3] = sigmoidf_fast(__uint_as_float(g_.y & 0xffff0000u));
                    g1[0] = sigmoidf_fast(__uint_as_float(g_.z << 16)); g1[1] = sigmoidf_fast(__uint_as_float(g_.z & 0xffff0000u)); g1[2] = sigmoidf_fast(__uint_as_float(g_.w << 16)); g1[3] = sigmoidf_fast(__uint_as_float(g_.w & 0xffff0000u));
                    f32x4 v0 = g0 * acc[ai][bj][m][0], v1 = g1 * acc[ai][bj][m][1];
                    if (MODE >= 1) { const u32x4 q = mw[m][bj];
                        v0[0] += __uint_as_float(q.x << 16); v0[1] += __uint_as_float(q.x & 0xffff0000u); v0[2] += __uint_as_float(q.y << 16); v0[3] += __uint_as_float(q.y & 0xffff0000u);
                        v1[0] += __uint_as_float(q.z << 16); v1[1] += __uint_as_float(q.z & 0xffff0000u); v1[2] += __uint_as_float(q.w << 16); v1[3] += __uint_as_float(q.w & 0xffff0000u); }
                    u32x4 w; w.x = cvt_pk_bf16(v0[0], v0[1]); w.y = cvt_pk_bf16(v0[2], v0[3]); w.z = cvt_pk_bf16(v1[0], v1[1]); w.w = cvt_pk_bf16(v1[2], v1[3]);
                    *(u32x4*)(Mb + r * 2048 + c) = w; }
            __builtin_amdgcn_sched_barrier(0); }
    }
};
struct EpiResid {
    static constexpr bool PERM = false, AFTER_DRAIN = false;
    const float* xin; float* xout;
    __device__ __forceinline__ void operator()(const f32x4 (&acc)[2][2][4][2], const Unit& u, int wr, int wc, int fr, int fq) const {
        const int row0 = u.pm * BM + wr * 64 + fr, col0 = u.pn * BM + wc * 32 + 4 * fq;
#pragma unroll
        for (int ai = 0; ai < 2; ++ai) {
            f32x4 xv[4][2][2];
#pragma unroll
            for (int m = 0; m < 4; ++m)
#pragma unroll
                for (int bj = 0; bj < 2; ++bj)
#pragma unroll
                    for (int n = 0; n < 2; ++n) xv[m][bj][n] = __builtin_nontemporal_load((const f32x4*)(xin + (size_t)(row0 + ai * HALF + m * 16) * 2048 + col0 + bj * HALF + n * 16));
            __builtin_amdgcn_sched_barrier(0);
#pragma unroll
            for (int m = 0; m < 4; ++m)
#pragma unroll
                for (int bj = 0; bj < 2; ++bj)
#pragma unroll
                    for (int n = 0; n < 2; ++n) *(f32x4*)(xout + (size_t)(row0 + ai * HALF + m * 16) * 2048 + col0 + bj * HALF + n * 16) = xv[m][bj][n] + acc[ai][bj][m][n];
            __builtin_amdgcn_sched_barrier(0); }
    }
};
struct EpiSwiglu {
    static constexpr bool PERM = true, AFTER_DRAIN = false;
    bf16_t* act; const float* sr;
    __device__ __forceinline__ void operator()(const f32x4 (&acc)[2][2][4][2], const Unit& u, int wr, int wc, int fr, int fq) const {
        const int row0 = u.pm * BM + wr * 64 + fr, col0 = (u.pn & 3) * 128 + wc * 32 + 8 * fq;
        float rs[2][4];
#pragma unroll
        for (int ai = 0; ai < 2; ++ai)
#pragma unroll
            for (int m = 0; m < 4; ++m) rs[ai][m] = sr[row0 + ai * HALF + m * 16];
        __builtin_amdgcn_sched_barrier(0);
#pragma unroll
        for (int ai = 0; ai < 2; ++ai)
#pragma unroll
            for (int m = 0; m < 4; ++m) { bf16_t* rowp = act + (size_t)(row0 + ai * HALF + m * 16) * 512 + col0;
                float o[8];
#pragma unroll
                for (int n = 0; n < 2; ++n)
#pragma unroll
                    for (int i = 0; i < 4; ++i) { const float g = acc[ai][0][m][n][i] * rs[ai][m], up = acc[ai][1][m][n][i] * rs[ai][m]; o[4 * n + i] = g * sigmoidf_fast(g) * up; }
                u32x4 w; w.x = cvt_pk_bf16(o[0], o[1]); w.y = cvt_pk_bf16(o[2], o[3]); w.z = cvt_pk_bf16(o[4], o[5]); w.w = cvt_pk_bf16(o[6], o[7]);
                *(u32x4*)rowp = w; }
    }
};
struct EpiDown {
    static constexpr bool PERM = true, AFTER_DRAIN = false;
    bf16_t* Y; const float* sw;
    __device__ __forceinline__ void operator()(const f32x4 (&acc)[2][2][4][2], const Unit& u, int wr, int wc, int fr, int fq) const {
        const int row0 = u.pm * BM + wr * 64 + fr, col0 = (u.pn & 7) * 256 + wc * 32 + 8 * fq;
        float swv[2][4];
#pragma unroll
        for (int ai = 0; ai < 2; ++ai)
#pragma unroll
            for (int m = 0; m < 4; ++m) swv[ai][m] = sw[row0 + ai * HALF + m * 16];
        __builtin_amdgcn_sched_barrier(0);
#pragma unroll
        for (int ai = 0; ai < 2; ++ai)
#pragma unroll
            for (int m = 0; m < 4; ++m) { const int r = row0 + ai * HALF + m * 16; const float s = swv[ai][m]; bf16_t* rowp = Y + (size_t)r * 2048 + col0;
#pragma unroll
                for (int bj = 0; bj < 2; ++bj) { const f32x4 v0 = acc[ai][bj][m][0] * s, v1 = acc[ai][bj][m][1] * s;
                    u32x4 w; w.x = cvt_pk_bf16(v0[0], v0[1]); w.y = cvt_pk_bf16(v0[2], v0[3]); w.z = cvt_pk_bf16(v1[0], v1[1]); w.w = cvt_pk_bf16(v1[2], v1[3]);
                    *(u32x4*)(rowp + bj * HALF) = w; } }
    }
};
struct MoeOrder {
    const int* tab; int ncol, G, c;
    __device__ __forceinline__ bool next(int i, Unit& u) const {
        if (G & 7) { const int nrt = __builtin_amdgcn_readfirstlane(tab[256]); const int L = i * G + c; if (L >= nrt * ncol) return false;
            const int R = L / ncol, j = L - R * ncol; u.pm = R; u.pn = __builtin_amdgcn_readfirstlane(tab[R]) * ncol + j; return true; }
        const int x = c & 7, r = c >> 3, W = G >> 3; const int* xo = tab + 320 + 9 * x;
        const int L = i * W + r; if (L >= __builtin_amdgcn_readfirstlane(xo[8]) * ncol) return false;
        const int ut = L / ncol, j = L - ut * ncol; int k = 0, base = 0;
#pragma unroll
        for (int kk = 1; kk < 8; ++kk) { const int v = __builtin_amdgcn_readfirstlane(xo[kk]); if (ut >= v) { k = kk; base = v; } }
        const int e = x + 8 * k; u.pm = __builtin_amdgcn_readfirstlane(tab[400 + e]) + (ut - base); u.pn = e * ncol + j; return true;
    }
    __device__ __forceinline__ void a_ready(const Unit&) const {}
    __device__ __forceinline__ void done(const Unit&) const {}
};
template <class Epi, class Sched, bool ALIGN_EPI = false, bool SP2 = false>
__device__ __forceinline__ void gemm_phase(PG8_LAS unsigned char* lds, const Gemm g, const Sched& S, const Epi& E) {
    int tid_ = threadIdx.x; asm volatile("" : "+v"(tid_));
    const int tid = tid_, wid = __builtin_amdgcn_readfirstlane(tid >> 6), lane = tid & 63, wr = wid >> 2, wc = wid & 3, fr = lane & 15, fq = lane >> 4;
    const int K = g.K, nt = K / BK;
    unsigned voffA[2], voffB[2];
#pragma unroll
    for (int i = 0; i < 2; ++i) { int R, C; stage_rc(tid * 16 + i * 8192, R, C); const int Rb = Epi::PERM ? ((R & ~31) + perm32(R & 31)) : R;
        voffA[i] = (unsigned)(R * K + C) * 2u; voffB[i] = (unsigned)(Rb * K + C) * 2u; }
    const size_t kstep = (size_t)(BK * 2);
    const size_t hstep = (size_t)HALF * K * 2;
    const size_t tstep = 2 * hstep;
    const unsigned ldsw = (unsigned)wid * 1024u;
    const int aoff = lds_byte(wr * 64 + fr, fq * 8), boff = lds_byte(wc * 32 + fr, fq * 8);
#define PG8_SA(b, h) (((b) * 2 + (h)) * HTB)
#define PG8_SB(b, h) ((4 + (b) * 2 + (h)) * HTB)
#define PG8_STAGE(bufoff, gbase, voff) do { _Pragma("unroll") for (int _i = 0; _i < 2; ++_i) \
        __builtin_amdgcn_global_load_lds((const unsigned*)((const char*)(gbase) + (voff)[_i]), (PG8_LAS unsigned*)(lds + (bufoff) + ldsw + _i * 8192), 16, 0, 0); } while (0)
#define PG8_LDA(dst, b, h) do { _Pragma("unroll") for (int m = 0; m < 4; ++m) _Pragma("unroll") for (int k = 0; k < 2; ++k) dst[m][k] = *(const PG8_LAS bf16x8*)(lds + PG8_SA(b, h) + aoff + m * 2048 + k * 1024); } while (0)
#define PG8_LDB(dst, b, h) do { _Pragma("unroll") for (int n = 0; n < 2; ++n) _Pragma("unroll") for (int k = 0; k < 2; ++k) dst[n][k] = *(const PG8_LAS bf16x8*)(lds + PG8_SB(b, h) + boff + n * 2048 + k * 1024); } while (0)
#define PG8_MMA(ai, bj, At, Bt) do { __builtin_amdgcn_s_setprio(1); _Pragma("unroll") for (int m = 0; m < 4; ++m) _Pragma("unroll") for (int n = 0; n < 2; ++n) _Pragma("unroll") for (int k = 0; k < 2; ++k) \
        acc[ai][bj][m][n] = __builtin_amdgcn_mfma_f32_16x16x32_bf16(Bt[n][k], At[m][k], acc[ai][bj][m][n], 0, 0, 0); __builtin_amdgcn_s_setprio(0); } while (0)
#define PG8_WAIT_V(n) asm volatile("s_waitcnt vmcnt(" #n ")" ::: "memory")
#define PG8_WAIT_L(n) asm volatile("s_waitcnt lgkmcnt(" #n ")" ::: "memory")
#define PG8_BAR __builtin_amdgcn_s_barrier()
#define PG8_SCHED __builtin_amdgcn_sched_barrier(0)
    Unit cur, nxt; int ui = 0;
    if (!S.next(0, cur)) return;
    f32x4 acc[2][2][4][2];
#pragma unroll
    for (int a = 0; a < 2; ++a)
#pragma unroll
        for (int b = 0; b < 2; ++b)
#pragma unroll
            for (int m = 0; m < 4; ++m)
#pragma unroll
                for (int n = 0; n < 2; ++n) acc[a][b][m][n] = (f32x4){0.f, 0.f, 0.f, 0.f};
    bf16x8 At[4][2], B0[2][2], B1[2][2];
    const char* cA = (const char*)g.A + (size_t)cur.pm * tstep; const char* cB = (const char*)g.Bt + (size_t)cur.pn * tstep;
    S.a_ready(cur);
    if constexpr (SP2) {
        PG8_STAGE(PG8_SB(0, 0), cB, voffB); PG8_STAGE(PG8_SB(0, 1), cB + hstep, voffB); PG8_STAGE(PG8_SA(0, 0), cA, voffA); PG8_STAGE(PG8_SA(0, 1), cA + hstep, voffA);
        if (wr == 1) PG8_BAR;
        PG8_WAIT_V(2); PG8_BAR;
        PG8_STAGE(PG8_SB(1, 0), cB + kstep, voffB); PG8_STAGE(PG8_SA(1, 0), cA + kstep, voffA); PG8_STAGE(PG8_SB(1, 1), cB + hstep + kstep, voffB);
        PG8_WAIT_V(6); PG8_BAR;
    } else {
        PG8_STAGE(PG8_SB(0, 0), cB, voffB); PG8_STAGE(PG8_SA(0, 0), cA, voffA); PG8_STAGE(PG8_SB(0, 1), cB + hstep, voffB); PG8_STAGE(PG8_SA(0, 1), cA + hstep, voffA);
        if (wr == 1) PG8_BAR;
        PG8_WAIT_V(4); PG8_BAR;
        PG8_STAGE(PG8_SB(1, 0), cB + kstep, voffB); PG8_STAGE(PG8_SA(1, 0), cA + kstep, voffA); PG8_STAGE(PG8_SB(1, 1), cB + hstep + kstep, voffB);
        PG8_WAIT_V(6); PG8_BAR;
    }
    for (;;) {
        const bool has_next = S.next(ui + 1, nxt);
        const char* nA = has_next ? (const char*)g.A + (size_t)nxt.pm * tstep : cA; const char* nB = has_next ? (const char*)g.Bt + (size_t)nxt.pn * tstep : cB;
        for (int t = 0; t < nt; t += 2) {
            const bool last = (t == nt - 2);
            const char* a1 = cA + (size_t)(t + 1) * kstep;
            const char* a2 = last ? nA : cA + (size_t)(t + 2) * kstep; const char* b2 = last ? nB : cB + (size_t)(t + 2) * kstep;
            const char* a3 = a2 + kstep; const char* b3 = b2 + kstep;
            if (last && has_next) S.a_ready(nxt);
            if constexpr (SP2) {
            PG8_LDB(B0, 0, 0); PG8_LDB(B1, 0, 1); PG8_SCHED; PG8_LDA(At, 0, 0); PG8_STAGE(PG8_SA(1, 1), a1 + hstep, voffA);
            PG8_WAIT_V(8); PG8_WAIT_L(0); PG8_BAR; PG8_MMA(0, 0, At, B0); PG8_MMA(0, 1, At, B1); PG8_BAR; PG8_SCHED;
            PG8_LDA(At, 0, 1); PG8_STAGE(PG8_SB(0, 0), b2, voffB); PG8_STAGE(PG8_SB(0, 1), b2 + hstep, voffB); PG8_STAGE(PG8_SA(0, 0), a2, voffA);
            PG8_WAIT_V(8); PG8_WAIT_L(0); PG8_BAR; PG8_MMA(1, 0, At, B0); PG8_MMA(1, 1, At, B1); PG8_BAR; PG8_SCHED;
            PG8_LDB(B0, 1, 0); PG8_LDB(B1, 1, 1); PG8_SCHED; PG8_LDA(At, 1, 0); PG8_STAGE(PG8_SA(0, 1), a2 + hstep, voffA);
            PG8_WAIT_V(8); PG8_WAIT_L(0); PG8_BAR; PG8_MMA(0, 0, At, B0); PG8_MMA(0, 1, At, B1); PG8_BAR; PG8_SCHED;
            PG8_LDA(At, 1, 1); PG8_STAGE(PG8_SB(1, 0), b3, voffB); PG8_STAGE(PG8_SB(1, 1), b3 + hstep, voffB); PG8_STAGE(PG8_SA(1, 0), a3, voffA);
            PG8_WAIT_V(8); PG8_WAIT_L(0); PG8_BAR; PG8_MMA(1, 0, At, B0); PG8_MMA(1, 1, At, B1); PG8_BAR; PG8_SCHED;
            } else {
            PG8_LDB(B0, 0, 0); PG8_SCHED; PG8_LDA(At, 0, 0); PG8_STAGE(PG8_SA(1, 1), a1 + hstep, voffA);
            PG8_WAIT_L(8); PG8_BAR; PG8_WAIT_L(0); PG8_MMA(0, 0, At, B0); PG8_BAR; PG8_SCHED;
            PG8_LDB(B1, 0, 1); PG8_STAGE(PG8_SB(0, 0), b2, voffB);
            PG8_BAR; PG8_WAIT_L(0); PG8_MMA(0, 1, At, B1); PG8_BAR;
            PG8_LDA(At, 0, 1); PG8_STAGE(PG8_SA(0, 0), a2, voffA);
            PG8_BAR; PG8_WAIT_L(0); PG8_MMA(1, 0, At, B0); PG8_BAR; PG8_SCHED;
            PG8_STAGE(PG8_SB(0, 1), b2 + hstep, voffB);
            PG8_WAIT_V(6); PG8_BAR; PG8_MMA(1, 1, At, B1); PG8_BAR;
            PG8_LDB(B0, 1, 0); PG8_SCHED; PG8_LDA(At, 1, 0); PG8_STAGE(PG8_SA(0, 1), a2 + hstep, voffA);
            PG8_WAIT_L(8); PG8_BAR; PG8_WAIT_L(0); PG8_MMA(0, 0, At, B0); PG8_BAR; PG8_SCHED;
            PG8_LDB(B1, 1, 1); PG8_STAGE(PG8_SB(1, 0), b3, voffB);
            PG8_BAR; PG8_WAIT_L(0); PG8_MMA(0, 1, At, B1); PG8_BAR;
            PG8_LDA(At, 1, 1); PG8_STAGE(PG8_SA(1, 0), a3, voffA);
            PG8_BAR; PG8_WAIT_L(0); PG8_MMA(1, 0, At, B0); PG8_BAR; PG8_SCHED;
            PG8_STAGE(PG8_SB(1, 1), b3 + hstep, voffB);
            PG8_WAIT_V(6); PG8_BAR; PG8_MMA(1, 1, At, B1); PG8_BAR;
            }
        }
        if constexpr (ALIGN_EPI) { if (wr == 0) PG8_BAR; }
        if constexpr (!Epi::AFTER_DRAIN) { E(acc, cur, wr, wc, fr, fq); S.done(cur); }
        if (!has_next) break;
#pragma unroll
        for (int a = 0; a < 2; ++a)
#pragma unroll
            for (int b = 0; b < 2; ++b)
#pragma unroll
                for (int m = 0; m < 4; ++m)
#pragma unroll
                    for (int n = 0; n < 2; ++n) acc[a][b][m][n] = (f32x4){0.f, 0.f, 0.f, 0.f};
        cur = nxt; cA = nA; cB = nB; ++ui;
        if constexpr (ALIGN_EPI) { if (wr == 1) PG8_BAR; }
    }
    PG8_WAIT_V(0);
    if constexpr (!ALIGN_EPI) { if (wr == 0) PG8_BAR; }
    PG8_BAR;
    if constexpr (Epi::AFTER_DRAIN) { E.fused(acc, cur, wr, wc, fr, fq, lds, wid, lane); S.done(cur); }
#undef PG8_SA
#undef PG8_SB
#undef PG8_STAGE
#undef PG8_LDA
#undef PG8_LDB
#undef PG8_MMA
#undef PG8_WAIT_V
#undef PG8_WAIT_L
#undef PG8_BAR
#undef PG8_SCHED
}
}
constexpr int NWAVES = 8;
constexpr int NTOK = 16384, DM = 2048, SEQ = 4096, NBATCH = 4, NH = 16, DEPTH = 2;
constexpr int DIN = 13392, NBIG = 13312;
constexpr int NEXP = 64, DEXP = 512, NASG = 2 * NTOK, MAXSLOT = 49152;
constexpr float EPS = 1e-6f, LOG2E = 1.4426950408889634f;

constexpr size_t MiB = 1u << 20;
constexpr size_t WS_CTL = 0, CTL_ZERO_BYTES = 1 * MiB;
constexpr size_t WS_TAB = 1 * MiB;
constexpr size_t WS_GN = 1 * MiB + 4096;
constexpr size_t WS_PART = 1 * MiB + 65536;
constexpr size_t WS_RS = 1 * MiB + 655360, WS_RS2 = 1 * MiB + 720896;
constexpr size_t WS_WIN = 2 * MiB, WS_WSK = 54 * MiB, WS_WUQ = 55 * MiB, WS_WUKV = 58 * MiB, WS_WBA = 62 * MiB, WS_WBB = 70 * MiB, WS_WBC = 74 * MiB,
                 WS_WOUT = 78 * MiB, WS_WRT = 86 * MiB, WS_WGU = 88 * MiB, WS_WD = 344 * MiB;
constexpr size_t WS_XN = 472 * MiB;
constexpr size_t WS_CQ = 536 * MiB, WS_CKV = 552 * MiB;
constexpr size_t WS_QKV6 = 568 * MiB;
constexpr size_t WS_GATES = 760 * MiB;
constexpr size_t WS_SK = 952 * MiB;
constexpr size_t WS_ROPE = 958 * MiB;
constexpr size_t WS_CUMF = 962 * MiB;
constexpr size_t WS_QM = 964 * MiB, WS_KM = 1060 * MiB;
constexpr size_t WS_VM = 1156 * MiB, WS_KNOPE = 1220 * MiB;
constexpr size_t WS_OA = 1284 * MiB, WS_OB = 1348 * MiB, WS_OC = 1380 * MiB;
constexpr size_t WS_MF = 1412 * MiB, WS_MB = 1540 * MiB;
constexpr size_t WS_HS = WS_QKV6;
constexpr size_t WS_ACT = WS_GATES;
constexpr size_t WS_Y = WS_QM;
constexpr size_t WS_ASG = 1604 * MiB;
constexpr size_t WS_XB = 1606 * MiB;
constexpr size_t WS_END = 1734 * MiB;
constexpr int CW_BAR = 4096;
constexpr int CW_AQ = 12288;
constexpr int CW_CNT = 8192;

constexpr int RING_OFF = 0, RING_BYTES = 139264;
constexpr int LDSCTL_OFF = RING_BYTES, MISC_OFF = LDSCTL_OFF + 320;
constexpr int LDS_BYTES = 147456;

#define GAS __attribute__((address_space(1)))
#define LAS __attribute__((address_space(3)))
typedef unsigned short bf16;
typedef unsigned v4u __attribute__((ext_vector_type(4)));
typedef unsigned v2u __attribute__((ext_vector_type(2)));
typedef float f32x4 __attribute__((ext_vector_type(4)));
typedef float f32x16 __attribute__((ext_vector_type(16)));
typedef short bf16x8 __attribute__((ext_vector_type(8)));
typedef short s16x4 __attribute__((ext_vector_type(4)));
typedef GAS unsigned gu32;
#define LDS_WAIT() asm volatile("s_waitcnt lgkmcnt(0)" ::: "memory")
#define VM_WAIT() asm volatile("s_waitcnt vmcnt(0)" ::: "memory")
__device__ __forceinline__ unsigned f2bf(float f) { unsigned u = __builtin_bit_cast(unsigned, f); return (u + 0x7fffu + ((u >> 16) & 1u)) >> 16; }
__device__ __forceinline__ unsigned pk2(float lo, float hi) { unsigned r; asm("v_cvt_pk_bf16_f32 %0, %1, %2" : "=v"(r) : "v"(lo), "v"(hi)); return r; }
__device__ __forceinline__ void glds16(const void* gsrc, unsigned lds_dst) { unsigned keep;
    asm volatile("s_mov_b32 %0, m0\n\ts_mov_b32 m0, %2\n\ts_nop 0\n\tglobal_load_lds_dwordx4 %1, off\n\ts_mov_b32 m0, %0" : "=&s"(keep) : "v"(gsrc), "s"(lds_dst) : "memory"); }
__device__ __forceinline__ void glds4(const void* gsrc, unsigned lds_dst) { unsigned keep;
    asm volatile("s_mov_b32 %0, m0\n\ts_mov_b32 m0, %2\n\ts_nop 0\n\tglobal_load_lds_dword %1, off\n\ts_mov_b32 m0, %0" : "=&s"(keep) : "v"(gsrc), "s"(lds_dst) : "memory"); }
__device__ __forceinline__ float bflo(unsigned w) { return __uint_as_float(w << 16); }
__device__ __forceinline__ float bfhi(unsigned w) { return __uint_as_float(w & 0xffff0000u); }
using pg8::bperm_xor;
__device__ __forceinline__ float bperm_up(float v, int d, int lane) { return __int_as_float(__builtin_amdgcn_ds_bpermute((lane - d) << 2, __float_as_int(v))); }
__device__ __forceinline__ float wave_sum(float v, int lane) {
#pragma unroll
    for (int o = 1; o < 64; o <<= 1) v += bperm_xor(v, o, lane);
    return v;
}
static_assert(pg8::EpiSeg::O_CQ == WS_CQ && pg8::EpiSeg::O_CKV == WS_CKV && pg8::EpiSeg::O_QKV6 == WS_QKV6 && pg8::EpiSeg::O_GATES == WS_GATES && pg8::EpiSeg::O_PART == WS_PART && pg8::EpiSeg::O_RS == WS_RS, "EpiSeg offsets vs workspace map");
#define XB_TMO      128
#define XB_XCNT(j)  (256  + 64 * (j))
#define XB_XSUB(j)  (1280 + 64 * (j))
#define XB_XGEN(j)  (2304 + 64 * (j))
#define XB_TOP      3328
#define XB_TOPGEN   3392
#define XCD_BAR_WORDS 3456
#define XB_SPIN_CAP (1u << 18)

__device__ __forceinline__ unsigned xb_ld(unsigned* p)              { return __hip_atomic_load(p, __ATOMIC_RELAXED, __HIP_MEMORY_SCOPE_AGENT); }
__device__ __forceinline__ unsigned xb_add(unsigned* p, unsigned v) { return __hip_atomic_fetch_add(p, v, __ATOMIC_RELAXED, __HIP_MEMORY_SCOPE_AGENT); }
__device__ __forceinline__ unsigned xb_xcc_id() { return (unsigned)__builtin_amdgcn_s_getreg((3 << 11) | 20) & 0xFu; }
#define XB_SPIN(cond, bar) do { unsigned _sp = 0; while (cond) { __builtin_amdgcn_s_sleep(1); \
    if ((++_sp & 255u) == 0u) { if (xb_ld(&(bar)[XB_TMO])) break; if (_sp > XB_SPIN_CAP) { atomicAdd(&(bar)[XB_TMO], 1u); break; } } } } while (0)

struct XcdBarrier {
    unsigned* bar; unsigned x;
    volatile LAS unsigned* st;
};

__device__ __forceinline__ XcdBarrier xcd_barrier_post(unsigned* bar, volatile LAS unsigned* st) {
    XcdBarrier b; b.bar = bar; b.x = xb_xcc_id(); b.st = st;
    if (threadIdx.x == 0) (void)xb_add(&bar[XB_XCNT(b.x)], 1u);
    return b;
}
__device__ __forceinline__ void xcd_barrier_complete(unsigned* bar, unsigned x, unsigned& nloc, unsigned& nx) {
    const unsigned G = gridDim.x * gridDim.y * gridDim.z;
    unsigned sum, cnt, mine, sp = 0u;
    for (;;) {
        sum = 0u; cnt = 0u; mine = 0u;
#pragma unroll
        for (unsigned j = 0; j < 16; ++j) { const unsigned c = xb_ld(&bar[XB_XCNT(j)]); sum += c; cnt += (c > 0u) ? 1u : 0u; mine = (j == x) ? c : mine; }
        if (sum == G) break;
        __builtin_amdgcn_s_sleep(1);
        if ((++sp & 255u) == 0u) { if (xb_ld(&bar[XB_TMO])) break; if (sp > XB_SPIN_CAP) { atomicAdd(&bar[XB_TMO], 1u); break; } }
    }
    nloc = mine > 0u ? mine : 1u; nx = cnt > 0u ? cnt : 1u;
}

__device__ __forceinline__ void xcd_barrier(const XcdBarrier& b) {
    asm volatile("s_waitcnt vmcnt(0)" ::: "memory");
    __syncthreads();
    if (threadIdx.x == 0) {
        unsigned* bar = b.bar;
        __builtin_amdgcn_s_waitcnt(0);
        unsigned nloc = b.st[0], nx = b.st[1];
        if (nloc == 0u) { xcd_barrier_complete(bar, b.x, nloc, nx); b.st[0] = nloc; b.st[1] = nx; }
        const unsigned old = xb_add(&bar[XB_XSUB(b.x)], 1u);
        const unsigned gen = old / nloc;
        if (old + 1u == (gen + 1u) * nloc) {
            __builtin_amdgcn_fence(__ATOMIC_RELEASE, "agent");
            asm volatile("s_waitcnt vmcnt(0)" ::: "memory");
            const unsigned og = xb_add(&bar[XB_TOP], 1u);
            const unsigned tg = og / nx;
            if (og + 1u == (tg + 1u) * nx) xb_add(&bar[XB_TOPGEN], 1u);
            else XB_SPIN(xb_ld(&bar[XB_TOPGEN]) == tg, bar);
            __builtin_amdgcn_fence(__ATOMIC_ACQUIRE, "agent");
            xb_add(&bar[XB_XGEN(b.x)], 1u);
            asm volatile("s_waitcnt vmcnt(0)" ::: "memory");
        } else {
            XB_SPIN(xb_ld(&bar[XB_XGEN(b.x)]) == gen, bar);
            __builtin_amdgcn_fence(__ATOMIC_ACQUIRE, "agent");
            asm volatile("s_waitcnt vmcnt(0)" ::: "memory");
        }
    }
    __syncthreads();
}

template <int PMODE = 0> __device__ __forceinline__ void conv_item64(const float* __restrict__ src, int ld, int K, int scol0, bf16* dst, int drow0, int nvalid, int kb, int lane, LAS unsigned char* tile, const float* kgain = nullptr, bool split = false) {
    const int g = lane >> 4, c = lane & 15, k0 = 64 * kb + 16 * g; const bool ok = 4 * c < nvalid;
    f32x4 v[16]; const float* p = src + (size_t)k0 * ld + scol0 + 4 * c;
#pragma unroll
    for (int i = 0; i < 16; ++i) v[i] = (ok && PMODE != 2) ? __builtin_nontemporal_load((const GAS f32x4*)(p + (size_t)i * ld)) : (f32x4){0.f, 0.f, 0.f, 0.f};
    if (kgain) {
#pragma unroll
        for (int i4 = 0; i4 < 4; ++i4) { const f32x4 kg = *(const GAS f32x4*)(kgain + k0 + 4 * i4); v[4 * i4] *= kg[0]; v[4 * i4 + 1] *= kg[1]; v[4 * i4 + 2] *= kg[2]; v[4 * i4 + 3] *= kg[3]; } }
#pragma unroll
    for (int j = 0; j < 4; ++j) { v4u o0, o1;
        o0.x = pk2(v[0][j], v[1][j]); o0.y = pk2(v[2][j], v[3][j]); o0.z = pk2(v[4][j], v[5][j]); o0.w = pk2(v[6][j], v[7][j]);
        o1.x = pk2(v[8][j], v[9][j]); o1.y = pk2(v[10][j], v[11][j]); o1.z = pk2(v[12][j], v[13][j]); o1.w = pk2(v[14][j], v[15][j]);
        LAS unsigned char* tp = tile + (4 * c + j) * 144 + 32 * g; *(LAS v4u*)tp = o0; *(LAS v4u*)(tp + 16) = o1; }
    LDS_WAIT(); asm volatile("" ::: "memory");
#pragma unroll
    for (int s = 0; s < 8; ++s) { const int row = (lane >> 3) + 8 * s, ch = lane & 7; const v4u w = *(const LAS v4u*)(tile + row * 144 + 16 * ch);
        const int drow = drow0 + row + ((split && row >= 32) ? 96 : 0);
        if (row < nvalid) { bf16* dp = dst + (size_t)drow * K + 64 * kb + 8 * ch;
            if (PMODE == 3) asm volatile("global_store_dwordx4 %0, %1, off sc0 sc1" :: "v"(dp), "v"(w) : "memory");
            else *(GAS v4u*)dp = w; } }
    LDS_WAIT(); asm volatile("" ::: "memory");
}
struct ConvSrc { const float *w_in, *w_uq, *w_ukv, *w_ba, *w_bb, *w_bc, *w_out, *g_cq, *g_ckv, *w_eg, *w_eu, *w_ed; };
template <int PMODE = 0> __device__ __forceinline__ void phase_convert(const ConvSrc& S, unsigned char* ws, int it_begin, int it_stride, int it_end, int lane, LAS unsigned char* tile) {
    bf16* WIN = (bf16*)(ws + WS_WIN); bf16* WUQ = (bf16*)(ws + WS_WUQ); bf16* WUKV = (bf16*)(ws + WS_WUKV);
    bf16* WBA = (bf16*)(ws + WS_WBA); bf16* WBB = (bf16*)(ws + WS_WBB); bf16* WBC = (bf16*)(ws + WS_WBC); bf16* WOUT = (bf16*)(ws + WS_WOUT);
    bf16* WGU = (bf16*)(ws + WS_WGU); bf16* WD = (bf16*)(ws + WS_WD);
    constexpr int I_IN0 = 16 * 32, I_IN1 = 96 * 32, I_IN2 = 96 * 32, I_SK0 = 1 * 32, I_SK1 = 1 * 32, I_UQ = 48 * 8, I_UKV = 64 * 8,
                  I_BA = 32 * 32, I_BB = 32 * 16, I_BC = 32 * 16, I_OUT = 32 * 32, I_GU = 16 * 32, I_D = 32 * 8, I_EXP = I_GU + I_D;
    constexpr int I_DENSE = I_IN0 + I_IN1 + I_IN2 + I_UQ + I_UKV + I_BA + I_BB + I_BC + I_OUT;
    constexpr int NITEMS = I_DENSE + NEXP * I_EXP;
    for (int it = it_begin; it < it_end; it += it_stride) {
        int r = it; const float* src; int ld, K, scol0, drow0, nvalid = 64, kb, nblk = 1; bf16* dst; const float* kg = nullptr; bool split = false; int jobid = 0;
        if (r >= I_DENSE) { r -= I_DENSE; const int e = r / I_EXP; r -= e * I_EXP;
            if (r < I_GU) { const int b = r & 15; kb = r >> 4; const int j = b >> 2, t = b & 3; ld = 512; K = 2048; dst = WGU + (size_t)e * 1024 * 2048; drow0 = 64 * b;
                if (t < 2) { src = S.w_eg + (size_t)e * 2048 * 512; scol0 = 128 * j + 64 * t; } else { src = S.w_eu + (size_t)e * 2048 * 512; scol0 = 128 * j + 64 * (t - 2); } }
            else { r -= I_GU; const int b = r & 31; kb = r >> 5; ld = 2048; K = 512; src = S.w_ed + (size_t)e * 512 * 2048; scol0 = 64 * b; dst = WD + (size_t)e * 2048 * 512; drow0 = 64 * b; }
        } else {
            if (r < I_IN0) { src = S.w_in; ld = DIN; K = 2048; nblk = 16; scol0 = 0; dst = WIN; drow0 = 0; }
            else if ((r -= I_IN0) < I_IN1) { src = S.w_in; ld = DIN; K = 2048; nblk = 96; scol0 = 1088; dst = WIN; drow0 = 1024; jobid = 1; }
            else if ((r -= I_IN1) < I_IN2) { src = S.w_in; ld = DIN; K = 2048; nblk = 96; scol0 = 7248; dst = WIN; drow0 = 7168; }
            else if ((r -= I_IN2) < I_UQ) { src = S.w_uq; ld = 3072; K = 512; nblk = 48; scol0 = 0; dst = WUQ; drow0 = 0; kg = S.g_cq; }
            else if ((r -= I_UQ) < I_UKV) { src = S.w_ukv; ld = 4096; K = 512; nblk = 64; scol0 = 0; dst = WUKV; drow0 = 0; kg = S.g_ckv; }
            else if ((r -= I_UKV) < I_BA) { src = S.w_ba; ld = 2048; K = 2048; nblk = 32; scol0 = 0; dst = WBA; drow0 = 0; }
            else if ((r -= I_BA) < I_BB) { src = S.w_bb; ld = 2048; K = 1024; nblk = 32; scol0 = 0; dst = WBB; drow0 = 0; }
            else if ((r -= I_BB) < I_BC) { src = S.w_bc; ld = 2048; K = 1024; nblk = 32; scol0 = 0; dst = WBC; drow0 = 0; }
            else { r -= I_BC; src = S.w_out; ld = 2048; K = 2048; nblk = 32; scol0 = 0; dst = WOUT; drow0 = 0; }
            const int b = r % nblk; kb = r / nblk; scol0 += 64 * b; drow0 += 64 * b;
            if (jobid == 1) { const int seg = b >> 4;
                if (seg != 2 && seg != 5) { split = true; drow0 = 1024 + 256 * (b >> 2) + 32 * (b & 3); } }
        }
        conv_item64<PMODE>(src, ld, K, scol0, dst, drow0, nvalid, kb, lane, tile, kg, split);
    }
}
constexpr int CONV_EXP_ITEMS = NEXP * (16 * 32 + 32 * 8);
struct ConvItem { const float* src; bf16* dst; int ld, K, scol0, drow0, kb; };
__device__ __forceinline__ ConvItem conv_expert_decode(const float* w_eg, const float* w_eu, const float* w_ed, bf16* WGU, bf16* WD, int it) {
    ConvItem I; const int e = it / 768; int r = it - e * 768;
    if (r < 512) { const int b = r & 15; I.kb = r >> 4; const int j = b >> 2, t = b & 3; I.ld = 512; I.K = 2048; I.dst = WGU + (size_t)e * 1024 * 2048; I.drow0 = 64 * b;
        if (t < 2) { I.src = w_eg + (size_t)e * 2048 * 512; I.scol0 = 128 * j + 64 * t; } else { I.src = w_eu + (size_t)e * 2048 * 512; I.scol0 = 128 * j + 64 * (t - 2); } }
    else { r -= 512; const int b = r & 31; I.kb = r >> 5; I.ld = 2048; I.K = 512; I.src = w_ed + (size_t)e * 512 * 2048; I.scol0 = 64 * b; I.dst = WD + (size_t)e * 2048 * 512; I.drow0 = 64 * b; }
    return I;
}
__device__ __forceinline__ void conv_load64(const ConvItem& I, int lane, f32x4 (&v)[16]) {
    const int g = lane >> 4, c = lane & 15, k0 = 64 * I.kb + 16 * g; const float* p = I.src + (size_t)k0 * I.ld + I.scol0 + 4 * c;
#pragma unroll
    for (int i = 0; i < 16; ++i) v[i] = __builtin_nontemporal_load((const GAS f32x4*)(p + (size_t)i * I.ld));
}
__device__ __forceinline__ void conv_store64(const ConvItem& I, int lane, LAS unsigned char* tile, const f32x4 (&v)[16]) {
    const int g = lane >> 4, c = lane & 15;
#pragma unroll
    for (int j = 0; j < 4; ++j) { v4u o0, o1;
        o0.x = pk2(v[0][j], v[1][j]); o0.y = pk2(v[2][j], v[3][j]); o0.z = pk2(v[4][j], v[5][j]); o0.w = pk2(v[6][j], v[7][j]);
        o1.x = pk2(v[8][j], v[9][j]); o1.y = pk2(v[10][j], v[11][j]); o1.z = pk2(v[12][j], v[13][j]); o1.w = pk2(v[14][j], v[15][j]);
        LAS unsigned char* tp = tile + (4 * c + j) * 144 + 32 * g; *(LAS v4u*)tp = o0; *(LAS v4u*)(tp + 16) = o1; }
    LDS_WAIT(); asm volatile("" ::: "memory");
#pragma unroll
    for (int s = 0; s < 8; ++s) { const int row = (lane >> 3) + 8 * s, ch = lane & 7; const v4u w = *(const LAS v4u*)(tile + row * 144 + 16 * ch);
        __builtin_nontemporal_store(w, (GAS v4u*)(I.dst + (size_t)(I.drow0 + row) * I.K + 64 * I.kb + 8 * ch)); }
    LDS_WAIT(); asm volatile("" ::: "memory");
}
__device__ __forceinline__ ConvItem conv_late_dense_decode(const float* w_ba, const float* w_bb, const float* w_bc, const float* w_out, unsigned char* ws, int d) {
    ConvItem I; I.ld = 2048; int r = d;
    if (r < 1024) { I.src = w_ba; I.dst = (bf16*)(ws + WS_WBA); I.K = 2048; }
    else if ((r -= 1024) < 512) { I.src = w_bb; I.dst = (bf16*)(ws + WS_WBB); I.K = 1024; }
    else if ((r -= 512) < 512) { I.src = w_bc; I.dst = (bf16*)(ws + WS_WBC); I.K = 1024; }
    else { r -= 512; I.src = w_out; I.dst = (bf16*)(ws + WS_WOUT); I.K = 2048; }
    const int b = r & 31; I.kb = r >> 5; I.scol0 = 64 * b; I.drow0 = 64 * b; return I;
}
__device__ __forceinline__ void conv_expert_items(const float* w_eg, const float* w_eu, const float* w_ed, const float* w_ba, const float* w_bb, const float* w_bc, const float* w_out, unsigned char* ws, int first, int dense_item, LAS unsigned char* tile) {
    int t_ = threadIdx.x; asm volatile("" : "+v"(t_)); const int lane = t_ & 63;
    bf16* WGU = (bf16*)(ws + WS_WGU); bf16* WD = (bf16*)(ws + WS_WD);
    f32x4 va[16], vb[16];
    ConvItem Ia = conv_expert_decode(w_eg, w_eu, w_ed, WGU, WD, first), Ib;
    conv_load64(Ia, lane, va);
#pragma unroll 1
    for (int j = 0; j < 16; j += 2) {
        Ib = conv_expert_decode(w_eg, w_eu, w_ed, WGU, WD, first + (j + 1) * 8);
        conv_load64(Ib, lane, vb); __builtin_amdgcn_sched_barrier(0);
        conv_store64(Ia, lane, tile, va); __builtin_amdgcn_sched_barrier(0);
        Ia = (j + 2 < 16) ? conv_expert_decode(w_eg, w_eu, w_ed, WGU, WD, first + (j + 2) * 8) : conv_late_dense_decode(w_ba, w_bb, w_bc, w_out, ws, dense_item);
        conv_load64(Ia, lane, va); __builtin_amdgcn_sched_barrier(0);
        conv_store64(Ib, lane, tile, vb); __builtin_amdgcn_sched_barrier(0);
    }
    conv_store64(Ia, lane, tile, va);
}
__device__ __forceinline__ void phase_convert_small(const float* w_in_l, const float* w_group_l, const float* w_router_l, bf16* WSK, bf16* WRT, int tid_g, int nthr_g) {
    for (int i = tid_g; i < 2 * 80 * 256; i += nthr_g) { const int which = i / (80 * 256), r = i - which * (80 * 256), n = r >> 8, k8 = r & 255; float v[8];
        if (which == 0) { const float* s = w_in_l + (size_t)(8 * k8) * DIN + (n < 64 ? 1024 + n : 7232 + (n - 64));
#pragma unroll
            for (int j = 0; j < 8; ++j) v[j] = s[(size_t)j * DIN]; }
        else {
#pragma unroll
            for (int j = 0; j < 8; ++j) { const int k = 8 * k8 + j; v[j] = n < 8 ? w_group_l[k * 8 + n] : (n < 72 ? w_router_l[k * 64 + (n - 8)] : 0.f); } }
        v4u o; o.x = pk2(v[0], v[1]); o.y = pk2(v[2], v[3]); o.z = pk2(v[4], v[5]); o.w = pk2(v[6], v[7]);
        const size_t idx = ((size_t)(((k8 >> 2) * 5 + (n >> 4)) * 64 + (k8 & 3) * 16 + (n & 15))) * 8;
        *(GAS v4u*)((which == 0 ? WSK : WRT) + idx) = o; }
}

__device__ __forceinline__ void phase_rmsnorm(const float* x, const float* gain, bf16* out, int gw, int NGW, int lane) {
    f32x4 g[8];
#pragma unroll
    for (int j = 0; j < 8; ++j) g[j] = ((const GAS f32x4*)gain)[lane + 64 * j];
    for (int row = gw; row < NTOK; row += NGW) {
        const GAS f32x4* xr = (const GAS f32x4*)(x + (size_t)row * DM) + lane; f32x4 v[8]; float s = 0.f;
#pragma unroll
        for (int j = 0; j < 8; ++j) { v[j] = xr[64 * j]; s += (v[j].x * v[j].x + v[j].y * v[j].y) + (v[j].z * v[j].z + v[j].w * v[j].w); }
        const float r = 1.0f / sqrtf(wave_sum(s, lane) * (1.0f / DM) + EPS);
        GAS v2u* o = (GAS v2u*)(out + (size_t)row * DM) + lane;
#pragma unroll
        for (int j = 0; j < 8; ++j) { v2u w; w.x = pk2(v[j].x * r * g[j].x, v[j].y * r * g[j].y); w.y = pk2(v[j].z * r * g[j].z, v[j].w * r * g[j].w); o[64 * j] = w; }
    }
}

__device__ __forceinline__ void skinny16x80(const bf16* A, const bf16* Wt, int row0, int lane, f32x4 (&acc)[5]) {
#pragma unroll
    for (int t = 0; t < 5; ++t) acc[t] = (f32x4){0.f, 0.f, 0.f, 0.f};
    const bf16* ap = A + (size_t)(row0 + (lane & 15)) * 2048 + 8 * (lane >> 4);
    const bf16* bp = Wt + (size_t)(lane & 15) * 2048 + 8 * (lane >> 4);
#pragma unroll 4
    for (int k0 = 0; k0 < 2048; k0 += 32) {
        const bf16x8 a = *(const GAS bf16x8*)(ap + k0);
#pragma unroll
        for (int t = 0; t < 5; ++t) { const bf16x8 b = *(const GAS bf16x8*)(bp + (size_t)t * 16 * 2048 + k0); acc[t] = __builtin_amdgcn_mfma_f32_16x16x32_bf16(a, b, acc[t], 0, 0, 0); }
    }
}
__device__ __forceinline__ void phase_skinny_store(const bf16* A, const bf16* Wt, float* out, int gw, int NGW, int lane) {
    for (int rg = gw; rg < NTOK / 16; rg += NGW) { f32x4 acc[5]; skinny16x80(A, Wt, rg * 16, lane, acc);
#pragma unroll
        for (int t = 0; t < 5; ++t)
#pragma unroll
            for (int i = 0; i < 4; ++i) out[(size_t)(rg * 16 + 4 * (lane >> 4) + i) * 80 + 16 * t + (lane & 15)] = acc[t][i]; }
}

template <bool COMBINE, bool ROUTE>
__device__ __forceinline__ void phase_norm_skinny(const float* __restrict__ xsrc, float* __restrict__ xdst, const bf16* __restrict__ Y, const int* __restrict__ tslot, const float* __restrict__ gain, const bf16* __restrict__ Wf, bf16* __restrict__ XNo, float* __restrict__ RSo, float* __restrict__ out80,
                                                  unsigned* cnt, int* __restrict__ asg_e, int* __restrict__ asg_pos, float* __restrict__ asg_w, LAS unsigned char* lds, int gw, int NGW, int wave, int lane, const float* __restrict__ gkr = nullptr, const float* __restrict__ ropet = nullptr, float* __restrict__ ssro = nullptr) {
    constexpr int AST = 528;
    LAS unsigned char* at = lds + wave * (8 * AST);
    LAS float* lg = (LAS float*)(lds + 8 * 8 * AST + wave * 2560);
    const int kq = lane >> 4;
    for (int g8 = gw; g8 < NTOK / 8; g8 += NGW) {
        const int row0 = g8 * 8;
        const float* __restrict__ xb = xsrc + (size_t)row0 * DM + 4 * lane;
        int s0[8], s1[8];
        if (COMBINE) {
#pragma unroll
            for (int r = 0; r < 8; ++r) { s0[r] = __builtin_amdgcn_readfirstlane(tslot[2 * (row0 + r)]); s1[r] = __builtin_amdgcn_readfirstlane(tslot[2 * (row0 + r) + 1]); } }
        float ssr[8];
#pragma unroll
        for (int r = 0; r < 8; ++r) ssr[r] = 0.f;
        f32x4 acc[5];
#pragma unroll
        for (int t = 0; t < 5; ++t) acc[t] = (f32x4){0.f, 0.f, 0.f, 0.f};
        f32x4 xv[8]; v2u ya[8], yb[8]; bf16x8 wf[2][2][5]; f32x4 g4;
        const bf16* __restrict__ yl = Y + 4 * lane; const float* __restrict__ gl = gain + 4 * lane; bf16* __restrict__ xnl = XNo + (size_t)row0 * DM + 4 * lane; float* __restrict__ xdl = COMBINE ? xdst + (size_t)row0 * DM + 4 * lane : nullptr;
#define FNS_LOADX(c_) do { int co_ = 256 * (c_); asm volatile("" : "+s"(co_));        \
            _Pragma("unroll") for (int r = 0; r < 8; ++r) { xv[r] = __builtin_nontemporal_load((const GAS f32x4*)(xb + (r * DM + co_))); \
            if (COMBINE) { ya[r] = __builtin_nontemporal_load((const GAS v2u*)(yl + ((size_t)s0[r] * DM + co_))); yb[r] = __builtin_nontemporal_load((const GAS v2u*)(yl + ((size_t)s1[r] * DM + co_))); } } \
            g4 = *(const GAS f32x4*)(gl + co_); } while (0)
#define FNS_LOADW(buf, gb_) do { const bf16* __restrict__ wp_ = Wf + ((size_t)(2 * (gb_)) * 5 * 64 + lane) * 8; \
            _Pragma("unroll") for (int s = 0; s < 2; ++s) _Pragma("unroll") for (int t = 0; t < 5; ++t) wf[buf][s][t] = *(const GAS bf16x8*)(wp_ + (size_t)(s * 5 + t) * 512); } while (0)
        if (!COMBINE) FNS_LOADX(0);
        FNS_LOADW(0, 0);
#pragma unroll 1
        for (int c = 0; c < 8; ++c) {
            if (COMBINE) FNS_LOADX(c);
            __builtin_amdgcn_sched_barrier(0);
            int cs_ = 256 * c; asm volatile("" : "+s"(cs_));
#pragma unroll
            for (int r = 0; r < 8; ++r) { f32x4 a = xv[r];
                if (COMBINE) { a.x += bflo(ya[r].x) + bflo(yb[r].x); a.y += bfhi(ya[r].x) + bfhi(yb[r].x); a.z += bflo(ya[r].y) + bflo(yb[r].y); a.w += bfhi(ya[r].y) + bfhi(yb[r].y);
                    __builtin_nontemporal_store(a, (GAS f32x4*)(xdl + (r * DM + cs_))); }
                ssr[r] += (a.x * a.x + a.y * a.y) + (a.z * a.z + a.w * a.w);
                v2u p; p.x = pk2(a.x * g4.x, a.y * g4.y); p.y = pk2(a.z * g4.z, a.w * g4.w);
                *(GAS v2u*)(xnl + (r * DM + cs_)) = p;
                *(LAS v2u*)(at + r * AST + 8 * lane) = p; }
            LDS_WAIT(); __builtin_amdgcn_sched_barrier(0);
            if (!COMBINE && c + 1 < 8) FNS_LOADX(c + 1);
            const LAS unsigned char* ap = at + (lane & 7) * AST + 16 * kq;
#pragma unroll
            for (int q = 0; q < 4; ++q) {
                if (4 * c + q + 1 < 32) FNS_LOADW((q + 1) & 1, 4 * c + q + 1);
                __builtin_amdgcn_sched_barrier(0);
#pragma unroll
                for (int s = 0; s < 2; ++s) { const bf16x8 af = *(const LAS bf16x8*)(ap + 64 * (2 * q + s));
#pragma unroll
                    for (int t = 0; t < 5; ++t) acc[t] = __builtin_amdgcn_mfma_f32_16x16x32_bf16(af, wf[q & 1][s][t], acc[t], 0, 0, 0); }
                __builtin_amdgcn_sched_barrier(0); }
            LDS_WAIT(); __builtin_amdgcn_sched_barrier(0); }
#undef FNS_LOADX
#undef FNS_LOADW
        float rr[8];
#pragma unroll
        for (int r = 0; r < 8; ++r) rr[r] = 1.0f / sqrtf(wave_sum(ssr[r], lane) * (1.0f / DM) + EPS);
        if (lane < 8) { float rv = rr[0];
#pragma unroll
            for (int r = 1; r < 8; ++r) rv = (lane == r) ? rr[r] : rv;
            RSo[row0 + lane] = rv; }
#pragma unroll
        for (int i = 0; i < 4; ++i) { const float ri = (lane < 16) ? rr[i] : rr[4 + i];
#pragma unroll
            for (int t = 0; t < 5; ++t) acc[t][i] *= ri; }
        if (!ROUTE) {
            const int jl = lane & 15, rbase = row0 + 4 * (lane >> 4);
#pragma unroll
            for (int i = 0; i < 4; ++i) { float sq = (acc[0][i] * acc[0][i] + acc[1][i] * acc[1][i]) + (acc[2][i] * acc[2][i] + acc[3][i] * acc[3][i]);
                sq += bperm_xor(sq, 1, lane); sq += bperm_xor(sq, 2, lane); sq += bperm_xor(sq, 4, lane); sq += bperm_xor(sq, 8, lane);
                if (lane < 32 && jl == 0) ssro[rbase + i] = sq; }
            if (lane < 32) {
#pragma unroll
                for (int t = 0; t < 2; ++t) { const int jj = 16 * t + jl; const float g1 = gkr[jj], g2 = gkr[32 + jj];
#pragma unroll
                    for (int i = 0; i < 4; ++i) { const size_t rw = (size_t)(rbase + i); const float cc = ropet[rw * 32 + jj], sv = ropet[(size_t)NTOK * 32 + rw * 32 + jj];
                        const float x1 = acc[t][i] * g1, x2 = acc[t + 2][i] * g2;
                        out80[rw * 80 + jj] = x1 * cc - x2 * sv; out80[rw * 80 + 32 + jj] = x2 * cc + x1 * sv; } }
#pragma unroll
                for (int i = 0; i < 4; ++i) out80[(size_t)(rbase + i) * 80 + 64 + jl] = acc[4][i]; } }
        else {
            if (lane < 32) {
#pragma unroll
                for (int t = 0; t < 5; ++t)
#pragma unroll
                    for (int i = 0; i < 4; ++i) lg[(4 * (lane >> 4) + i) * 80 + 16 * t + (lane & 15)] = acc[t][i]; }
            LDS_WAIT(); asm volatile("" ::: "memory");
            if (lane < 8) { const LAS float* L = lg + lane * 80; const int rw = row0 + lane;
                float gm = L[0]; int gi = 0;
#pragma unroll
                for (int j = 1; j < 8; ++j) { const float v = L[j]; if (v > gm) { gm = v; gi = j; } }
                float den = 0.f;
#pragma unroll
                for (int j = 0; j < 8; ++j) den += expf(L[j] - gm);
                const float pg = 1.0f / den;
                const LAS float* E = L + 8 + 8 * gi; float v0 = E[0]; int i0 = 0;
#pragma unroll
                for (int j = 1; j < 8; ++j) { const float v = E[j]; if (v > v0) { v0 = v; i0 = j; } }
                float v1 = -INFINITY; int i1 = 0;
#pragma unroll
                for (int j = 0; j < 8; ++j) { const float v = E[j]; if (j != i0 && v > v1) { v1 = v; i1 = j; } }
                const float e1 = expf(v1 - v0), w0 = pg / (1.0f + e1), w1 = pg * e1 / (1.0f + e1);
                const int x0 = gi * 8 + i0, x1 = gi * 8 + i1;
                const int p0 = (int)atomicAdd(cnt + x0, 1u), p1 = (int)atomicAdd(cnt + x1, 1u);
                asg_e[2 * rw] = x0; asg_pos[2 * rw] = p0; asg_w[2 * rw] = w0; asg_e[2 * rw + 1] = x1; asg_pos[2 * rw + 1] = p1; asg_w[2 * rw + 1] = w1; }
            LDS_WAIT(); asm volatile("" ::: "memory");
        }
    }
}

__device__ __forceinline__ void phase_post_proj(unsigned char* ws, const float* g_cq, const float* g_ckv, const float* g_sbq, const float* g_sbk,
                                                const float* g_fq, const float* g_fk, int gw, int NGW, int lane) {
    for (int it = gw; it < 2 * NTOK; it += NGW) { const int which = it & 1, row = it >> 1;
        bf16* p = (bf16*)(ws + (which ? WS_CKV : WS_CQ)) + (size_t)row * 512 + 8 * lane; const float* g = (which ? g_ckv : g_cq) + 8 * lane;
        const v4u w = *(const GAS v4u*)p; float v[8] = {bflo(w.x), bfhi(w.x), bflo(w.y), bfhi(w.y), bflo(w.z), bfhi(w.z), bflo(w.w), bfhi(w.w)};
        float s = 0.f;
#pragma unroll
        for (int i = 0; i < 8; ++i) s += v[i] * v[i];
        const float r = 1.0f / sqrtf(wave_sum(s, lane) * (1.0f / 512.f) + EPS);
        v4u o; o.x = pk2(v[0] * r * g[0], v[1] * r * g[1]); o.y = pk2(v[2] * r * g[2], v[3] * r * g[3]); o.z = pk2(v[4] * r * g[4], v[5] * r * g[5]); o.w = pk2(v[6] * r * g[6], v[7] * r * g[7]);
        *(GAS v4u*)p = o; }
    for (int it = gw; it < 4 * NTOK; it += NGW) { const int which = it & 3, row = it >> 2; const int seg = (which & 1) + 3 * (which >> 1);
        bf16* p = (bf16*)(ws + WS_QKV6) + (size_t)seg * NTOK * 1024 + (size_t)row * 1024 + 16 * lane;
        const float* g = (which == 0 ? g_sbq : which == 1 ? g_sbk : which == 2 ? g_fq : g_fk) + 16 * (lane & 3);
        const float qs = (which & 1) ? 1.0f : 0.125f * LOG2E;
        const v4u w0 = *(const GAS v4u*)p, w1 = *(const GAS v4u*)(p + 8);
        float v[16] = {bflo(w0.x), bfhi(w0.x), bflo(w0.y), bfhi(w0.y), bflo(w0.z), bfhi(w0.z), bflo(w0.w), bfhi(w0.w), bflo(w1.x), bfhi(w1.x), bflo(w1.y), bfhi(w1.y), bflo(w1.z), bfhi(w1.z), bflo(w1.w), bfhi(w1.w)};
        float s = 0.f;
#pragma unroll
        for (int i = 0; i < 16; ++i) s += v[i] * v[i];
        s += bperm_xor(s, 1, lane); s += bperm_xor(s, 2, lane);
        const float r = qs / sqrtf(s * (1.0f / 64.f) + EPS);
        v4u o0, o1; o0.x = pk2(v[0] * r * g[0], v[1] * r * g[1]); o0.y = pk2(v[2] * r * g[2], v[3] * r * g[3]); o0.z = pk2(v[4] * r * g[4], v[5] * r * g[5]); o0.w = pk2(v[6] * r * g[6], v[7] * r * g[7]);
        o1.x = pk2(v[8] * r * g[8], v[9] * r * g[9]); o1.y = pk2(v[10] * r * g[10], v[11] * r * g[11]); o1.z = pk2(v[12] * r * g[12], v[13] * r * g[13]); o1.w = pk2(v[14] * r * g[14], v[15] * r * g[15]);
        *(GAS v4u*)p = o0; *(GAS v4u*)(p + 8) = o1; }
}

__device__ __forceinline__ void phase_rope(unsigned char* ws, const int* positions, int tid_g, int nthr_g) {
    float* cs = (float*)(ws + WS_ROPE); float* sn = cs + (size_t)NTOK * 32;
    for (int i = tid_g; i < NTOK * 32; i += nthr_g) { const int row = i >> 5, j = i & 31; const float inv = powf(10000.0f, -(float)(2 * j) / 64.0f); const float ang = (float)positions[row] * inv;
        cs[i] = cosf(ang); sn[i] = sinf(ang); }
}
__device__ __forceinline__ void phase_cumsum(unsigned char* ws, const float* f_bias, LAS unsigned char* lds, int vcu, int G, int tid, int lane) {
    LAS float* wt = (LAS float*)lds;
    for (int seq = vcu; seq < NBATCH * NH; seq += G) { const int b = seq >> 4, h = seq & 15; const float* sk = (const float*)(ws + WS_SK) + (size_t)(b * SEQ + 8 * tid) * 80 + 64 + h; const float fb = f_bias[h];
        float v[8];
#pragma unroll
        for (int i = 0; i < 8; ++i) v[i] = sk[i * 80];
        float run = 0.f;
#pragma unroll
        for (int i = 0; i < 8; ++i) { run -= __builtin_amdgcn_logf(1.0f + __builtin_amdgcn_exp2f(-LOG2E * (v[i] + fb))); v[i] = run; }
        float inc = run;
#pragma unroll
        for (int o = 1; o < 64; o <<= 1) { const float t2 = bperm_up(inc, o, lane); if (lane >= o) inc += t2; }
        if (lane == 63) wt[tid >> 6] = inc;
        __syncthreads();
        float base = inc - run;
        for (int w = 0; w < (tid >> 6); ++w) base += wt[w];
        float* cf = (float*)(ws + WS_CUMF) + (size_t)seq * SEQ + 8 * tid;
        *(GAS f32x4*)cf = (f32x4){base + v[0], base + v[1], base + v[2], base + v[3]}; *(GAS f32x4*)(cf + 4) = (f32x4){base + v[4], base + v[5], base + v[6], base + v[7]};
        __syncthreads(); }
}

__device__ __forceinline__ void phase_mla_finalize(unsigned char* ws, const float* __restrict__ g_k, int gw, int NGW, int lane) {
    const int head = lane >> 2, c = lane & 3;
    const float* __restrict__ cs = (const float*)(ws + WS_ROPE); const float* __restrict__ sn = cs + (size_t)NTOK * 32; const float* __restrict__ sk = (const float*)(ws + WS_SK);
    bf16* KM = (bf16*)(ws + WS_KM); const bf16* __restrict__ KN = (const bf16*)(ws + WS_KNOPE);
    f32x4 gk[12];
#pragma unroll
    for (int i = 0; i < 8; ++i) gk[i] = *(const GAS f32x4*)(g_k + 32 * c + 4 * i);
#pragma unroll
    for (int i = 0; i < 2; ++i) { gk[8 + i] = *(const GAS f32x4*)(g_k + 128 + 8 * c + 4 * i); gk[10 + i] = *(const GAS f32x4*)(g_k + 160 + 8 * c + 4 * i); }
    for (int row0 = 2 * gw; row0 < NTOK; row0 += 2 * NGW) {
        v4u kw[2][4]; f32x4 cv[2][2], sv[2][2], kr[2][4];
#pragma unroll
        for (int q = 0; q < 2; ++q) { const int row = row0 + q; const bf16* kn = KN + (size_t)row * 2048 + head * 128 + 32 * c;
#pragma unroll
            for (int j = 0; j < 4; ++j) kw[q][j] = *(const GAS v4u*)(kn + 8 * j);
#pragma unroll
            for (int i = 0; i < 2; ++i) { cv[q][i] = *(const GAS f32x4*)(cs + (size_t)row * 32 + 8 * c + 4 * i); sv[q][i] = *(const GAS f32x4*)(sn + (size_t)row * 32 + 8 * c + 4 * i);
                kr[q][i] = *(const GAS f32x4*)(sk + (size_t)row * 80 + 8 * c + 4 * i); kr[q][2 + i] = *(const GAS f32x4*)(sk + (size_t)row * 80 + 32 + 8 * c + 4 * i); } }
        __builtin_amdgcn_sched_barrier(0);
#pragma unroll
        for (int q = 0; q < 2; ++q) { bf16* kb_ = KM + (size_t)(row0 + q) * 3072 + head * 192; float v[48];
#pragma unroll
            for (int j = 0; j < 4; ++j) { const v4u w = kw[q][j]; v[8 * j] = bflo(w.x); v[8 * j + 1] = bfhi(w.x); v[8 * j + 2] = bflo(w.y); v[8 * j + 3] = bfhi(w.y); v[8 * j + 4] = bflo(w.z); v[8 * j + 5] = bfhi(w.z); v[8 * j + 6] = bflo(w.w); v[8 * j + 7] = bfhi(w.w); }
#pragma unroll
            for (int i = 0; i < 8; ++i) { v[32 + i] = kr[q][i >> 2][i & 3]; v[40 + i] = kr[q][2 + (i >> 2)][i & 3]; }
            float s = 0.f;
#pragma unroll
            for (int i = 0; i < 48; ++i) s += v[i] * v[i];
            s += bperm_xor(s, 1, lane); s += bperm_xor(s, 2, lane);
            const float r = 1.0f / sqrtf(s * (1.0f / 192.f) + EPS);
#pragma unroll
            for (int j = 0; j < 4; ++j) { v4u o; const f32x4 g0 = gk[2 * j], g1 = gk[2 * j + 1]; const float* x = v + 8 * j;
                o.x = pk2(x[0] * r * g0[0], x[1] * r * g0[1]); o.y = pk2(x[2] * r * g0[2], x[3] * r * g0[3]); o.z = pk2(x[4] * r * g1[0], x[5] * r * g1[1]); o.w = pk2(x[6] * r * g1[2], x[7] * r * g1[3]);
                *(GAS v4u*)(kb_ + 32 * c + 8 * j) = o; }
            float o1[8], o2[8];
#pragma unroll
            for (int i = 0; i < 8; ++i) { const float x1 = v[32 + i] * r * gk[8 + (i >> 2)][i & 3], x2 = v[40 + i] * r * gk[10 + (i >> 2)][i & 3], cc = cv[q][i >> 2][i & 3], ss = sv[q][i >> 2][i & 3]; o1[i] = x1 * cc - x2 * ss; o2[i] = x2 * cc + x1 * ss; }
            v4u a, b2; a.x = pk2(o1[0], o1[1]); a.y = pk2(o1[2], o1[3]); a.z = pk2(o1[4], o1[5]); a.w = pk2(o1[6], o1[7]); b2.x = pk2(o2[0], o2[1]); b2.y = pk2(o2[2], o2[3]); b2.z = pk2(o2[4], o2[5]); b2.w = pk2(o2[6], o2[7]);
            *(GAS v4u*)(kb_ + 128 + 8 * c) = a; *(GAS v4u*)(kb_ + 160 + 8 * c) = b2; }
        __builtin_amdgcn_sched_barrier(0);
    }
}

__device__ __forceinline__ void phase_route(unsigned char* ws, unsigned* cnt, LAS unsigned char* lds, int gw, int NGW, int wave, int lane) {
    const bf16* H = (const bf16*)(ws + WS_XN); const bf16* WRT = (const bf16*)(ws + WS_WRT);
    int* asg_e = (int*)(ws + WS_ASG); int* asg_pos = asg_e + NASG; float* asg_w = (float*)(asg_pos + NASG);
    LAS float* lg = (LAS float*)(lds + wave * 8192);
    for (int rg = gw; rg < NTOK / 16; rg += NGW) { f32x4 acc[5]; skinny16x80(H, WRT, rg * 16, lane, acc);
#pragma unroll
        for (int t = 0; t < 5; ++t)
#pragma unroll
            for (int i = 0; i < 4; ++i) lg[(4 * (lane >> 4) + i) * 80 + 16 * t + (lane & 15)] = acc[t][i];
        LDS_WAIT(); asm volatile("" ::: "memory");
        if (lane < 16) { const LAS float* L = lg + lane * 80; const int row = rg * 16 + lane;
            float gm = L[0]; int gi = 0;
#pragma unroll
            for (int j = 1; j < 8; ++j) { const float v = L[j]; if (v > gm) { gm = v; gi = j; } }
            float den = 0.f;
#pragma unroll
            for (int j = 0; j < 8; ++j) den += expf(L[j] - gm);
            const float pg = 1.0f / den;
            const LAS float* E = L + 8 + 8 * gi; float v0 = E[0]; int i0 = 0;
#pragma unroll
            for (int j = 1; j < 8; ++j) { const float v = E[j]; if (v > v0) { v0 = v; i0 = j; } }
            float v1 = -INFINITY; int i1 = 0;
#pragma unroll
            for (int j = 0; j < 8; ++j) { const float v = E[j]; if (j != i0 && v > v1) { v1 = v; i1 = j; } }
            const float e1 = expf(v1 - v0), w0 = pg / (1.0f + e1), w1 = pg * e1 / (1.0f + e1);
            const int x0 = gi * 8 + i0, x1 = gi * 8 + i1;
            const int p0 = (int)atomicAdd(cnt + x0, 1u), p1 = (int)atomicAdd(cnt + x1, 1u);
            asg_e[2 * row] = x0; asg_pos[2 * row] = p0; asg_w[2 * row] = w0; asg_e[2 * row + 1] = x1; asg_pos[2 * row + 1] = p1; asg_w[2 * row + 1] = w1; }
        LDS_WAIT(); asm volatile("" ::: "memory");
    }
}

__device__ __forceinline__ void phase_dispatch(unsigned char* ws, const unsigned* cnt, LAS unsigned char* lds, int gw, int NGW, int tid, int lane, int block) {
    LAS int* off = (LAS int*)lds;
    LAS int* cl = off + 72;
    if (tid < NEXP) cl[tid] = (int)__hip_atomic_load(cnt + tid, __ATOMIC_RELAXED, __HIP_MEMORY_SCOPE_AGENT);
    __syncthreads();
    if (tid == 0) { int a = 0; for (int e = 0; e < NEXP; ++e) { off[e] = a; a += ((cl[e] + 255) >> 8) << 8; } off[NEXP] = a; }
    __syncthreads();
    int* tile_e = (int*)(ws + WS_TAB); int* nrt_p = tile_e + 256;
    if (block == 0) { const int nrt = off[NEXP] >> 8; if (tid == 0) *nrt_p = nrt;
        for (int R = tid; R < nrt; R += NWAVES * 64) { int e = 0; while (e < NEXP - 1 && off[e + 1] <= 256 * R) ++e; tile_e[R] = e; }
        if (tid < NEXP) tile_e[400 + tid] = off[tid] >> 8;
        if (tid < 8) { int a = 0; for (int k = 0; k < 8; ++k) { tile_e[320 + 9 * tid + k] = a; a += (off[tid + 8 * k + 1] - off[tid + 8 * k]) >> 8; } tile_e[320 + 9 * tid + 8] = a; } }
    const int* asg_e = (const int*)(ws + WS_ASG); const int* asg_pos = asg_e + NASG; const float* asg_w = (const float*)(asg_pos + NASG);
    int* tslot = (int*)(asg_w + NASG); float* slot_w = (float*)(tslot + NASG); float* slot_r = slot_w + MAXSLOT; const float* RS2 = (const float*)(ws + WS_RS2);
    const bf16* H = (const bf16*)(ws + WS_XN); bf16* HS = (bf16*)(ws + WS_HS);
    for (int tok = 4 * gw; tok < NTOK; tok += 4 * NGW) {
        int sl[4][2]; v4u rv[4][4];
        { const v4u e0 = *(const GAS v4u*)(asg_e + 2 * tok), e1 = *(const GAS v4u*)(asg_e + 2 * tok + 4), p0 = *(const GAS v4u*)(asg_pos + 2 * tok), p1 = *(const GAS v4u*)(asg_pos + 2 * tok + 4);
          const unsigned ev[8] = {e0.x, e0.y, e0.z, e0.w, e1.x, e1.y, e1.z, e1.w}, pv[8] = {p0.x, p0.y, p0.z, p0.w, p1.x, p1.y, p1.z, p1.w};
#pragma unroll
          for (int a = 0; a < 8; ++a) sl[a >> 1][a & 1] = off[__builtin_amdgcn_readfirstlane((int)ev[a])] + __builtin_amdgcn_readfirstlane((int)pv[a]); }
#pragma unroll
        for (int q = 0; q < 4; ++q) { const GAS v4u* s = (const GAS v4u*)(H + (size_t)(tok + q) * DM) + lane;
#pragma unroll
            for (int j = 0; j < 4; ++j) rv[q][j] = __builtin_nontemporal_load(s + 64 * j); }
        __builtin_amdgcn_sched_barrier(0);
#pragma unroll
        for (int q = 0; q < 4; ++q)
#pragma unroll
            for (int k = 0; k < 2; ++k) { GAS v4u* d = (GAS v4u*)(HS + (size_t)sl[q][k] * DM) + lane;
#pragma unroll
                for (int j = 0; j < 4; ++j) d[64 * j] = rv[q][j];
                if (lane == 0) { const int a = 2 * (tok + q) + k; slot_w[sl[q][k]] = asg_w[a]; slot_r[sl[q][k]] = RS2[tok + q]; tslot[a] = sl[q][k]; } }
        __builtin_amdgcn_sched_barrier(0); }
    __syncthreads();
}

__device__ __forceinline__ void phase_combine(unsigned char* ws, float* x, int gw, int NGW, int lane) {
    const int* tslot = (const int*)(ws + WS_ASG) + 3 * NASG; const bf16* Y = (const bf16*)(ws + WS_Y);
    for (int row = 2 * gw; row < NTOK; row += 2 * NGW) { const v4u sv = *(const GAS v4u*)(tslot + 2 * row);
        const int s[4] = {__builtin_amdgcn_readfirstlane((int)sv.x), __builtin_amdgcn_readfirstlane((int)sv.y), __builtin_amdgcn_readfirstlane((int)sv.z), __builtin_amdgcn_readfirstlane((int)sv.w)};
        v2u ya[2][8], yb[2][8]; f32x4 xv[2][8];
#pragma unroll
        for (int q = 0; q < 2; ++q) { const GAS v2u* y0 = (const GAS v2u*)(Y + (size_t)s[2 * q] * DM) + lane; const GAS v2u* y1 = (const GAS v2u*)(Y + (size_t)s[2 * q + 1] * DM) + lane; const GAS f32x4* xr = (const GAS f32x4*)(x + (size_t)(row + q) * DM) + lane;
#pragma unroll
            for (int j = 0; j < 8; ++j) { ya[q][j] = __builtin_nontemporal_load(y0 + 64 * j); yb[q][j] = __builtin_nontemporal_load(y1 + 64 * j); xv[q][j] = __builtin_nontemporal_load(xr + 64 * j); } }
        __builtin_amdgcn_sched_barrier(0);
#pragma unroll
        for (int q = 0; q < 2; ++q) { GAS f32x4* xr = (GAS f32x4*)(x + (size_t)(row + q) * DM) + lane;
#pragma unroll
            for (int j = 0; j < 8; ++j) { const v2u a = ya[q][j], b = yb[q][j]; f32x4 v = xv[q][j];
                v.x += bflo(a.x) + bflo(b.x); v.y += bfhi(a.x) + bfhi(b.x); v.z += bflo(a.y) + bflo(b.y); v.w += bfhi(a.y) + bfhi(b.y); __builtin_nontemporal_store(v, xr + 64 * j); } }
        __builtin_amdgcn_sched_barrier(0); }
}
__device__ __forceinline__ int crow(int r, int hi) { return (r & 3) + 8 * (r >> 2) + 4 * hi; }
template <int DK, int DV, int MODE>
__device__ __forceinline__ void attn_unit(LAS unsigned char* lds, const bf16* Qg, const bf16* Kg, const bf16* Vg, bf16* Og, int pqk, int pv, int b, int h, int qb, const float* ckg, float sbound, const float* gq = nullptr, const float* rope = nullptr) {
    constexpr int KST = DK * 2 + 16, VST = DV * 2 + 64;
    constexpr int KBYTES = 64 * KST, VBYTES = 64 * VST, STAGE = KBYTES + VBYTES + 256;
    constexpr int KCH = DK / 8, VCH = DV / 8, NKL = 64 * KCH / 512, NVL = 64 * VCH / 512;
    static_assert(2 * STAGE <= RING_BYTES, "attention LDS");
    int tid_ = threadIdx.x; asm volatile("" : "+v"(tid_));
    const int tid = tid_, lane = tid & 63, r32 = lane & 31, hi = lane >> 5; const int wid = __builtin_amdgcn_readfirstlane(tid >> 6);
    const size_t rowbase = (size_t)b * SEQ; const int q0 = qb * 256;
    bf16x8 qr[DK / 16];
    { const bf16* qp = Qg + (rowbase + q0 + wid * 32 + r32) * pqk + h * DK + 8 * hi;
#pragma unroll
      for (int d0 = 0; d0 < DK / 16; ++d0) qr[d0] = *(const GAS bf16x8*)(qp + 16 * d0); }
    if (DK == 192) {
        float qf[12][8]; float ss = 0.f;
#pragma unroll
        for (int d0 = 0; d0 < 12; ++d0) { const v4u w = __builtin_bit_cast(v4u, qr[d0]);
            qf[d0][0] = bflo(w.x); qf[d0][1] = bfhi(w.x); qf[d0][2] = bflo(w.y); qf[d0][3] = bfhi(w.y); qf[d0][4] = bflo(w.z); qf[d0][5] = bfhi(w.z); qf[d0][6] = bflo(w.w); qf[d0][7] = bfhi(w.w);
#pragma unroll
            for (int j = 0; j < 8; ++j) ss += qf[d0][j] * qf[d0][j]; }
        { auto rr = __builtin_amdgcn_permlane32_swap(__float_as_uint(ss), __float_as_uint(ss), false, false); ss = __uint_as_float(rr[0]) + __uint_as_float(rr[1]); }
        const float rn = (0.07216878364870322f * LOG2E) / sqrtf(ss * (1.0f / 192.f) + EPS);
        const float* gp = gq + 8 * hi; const float* cs = rope + (size_t)(rowbase + q0 + wid * 32 + r32) * 32 + 8 * hi; const float* sn = cs + (size_t)NTOK * 32;
#pragma unroll
        for (int d0 = 0; d0 < 8; ++d0) { const f32x4 g0 = *(const GAS f32x4*)(gp + 16 * d0), g1 = *(const GAS f32x4*)(gp + 16 * d0 + 4); v4u w;
            w.x = pk2(qf[d0][0] * rn * g0[0], qf[d0][1] * rn * g0[1]); w.y = pk2(qf[d0][2] * rn * g0[2], qf[d0][3] * rn * g0[3]); w.z = pk2(qf[d0][4] * rn * g1[0], qf[d0][5] * rn * g1[1]); w.w = pk2(qf[d0][6] * rn * g1[2], qf[d0][7] * rn * g1[3]);
            qr[d0] = __builtin_bit_cast(bf16x8, w); }
#pragma unroll
        for (int d0 = 8; d0 < 10; ++d0) { const f32x4 ga0 = *(const GAS f32x4*)(gp + 16 * d0), ga1 = *(const GAS f32x4*)(gp + 16 * d0 + 4), gb0 = *(const GAS f32x4*)(gp + 16 * d0 + 32), gb1 = *(const GAS f32x4*)(gp + 16 * d0 + 36);
            const f32x4 c0 = *(const GAS f32x4*)(cs + 16 * (d0 - 8)), c1 = *(const GAS f32x4*)(cs + 16 * (d0 - 8) + 4), s0 = *(const GAS f32x4*)(sn + 16 * (d0 - 8)), s1 = *(const GAS f32x4*)(sn + 16 * (d0 - 8) + 4);
            float o1[8], o2[8];
#pragma unroll
            for (int j = 0; j < 8; ++j) { const float x1 = qf[d0][j] * rn * (j < 4 ? ga0[j & 3] : ga1[j & 3]), x2 = qf[d0 + 2][j] * rn * (j < 4 ? gb0[j & 3] : gb1[j & 3]), cc = (j < 4 ? c0[j & 3] : c1[j & 3]), sv = (j < 4 ? s0[j & 3] : s1[j & 3]);
                o1[j] = x1 * cc - x2 * sv; o2[j] = x2 * cc + x1 * sv; }
            v4u wa, wb; wa.x = pk2(o1[0], o1[1]); wa.y = pk2(o1[2], o1[3]); wa.z = pk2(o1[4], o1[5]); wa.w = pk2(o1[6], o1[7]); wb.x = pk2(o2[0], o2[1]); wb.y = pk2(o2[2], o2[3]); wb.z = pk2(o2[4], o2[5]); wb.w = pk2(o2[6], o2[7]);
            qr[d0] = __builtin_bit_cast(bf16x8, wa); qr[d0 + 2] = __builtin_bit_cast(bf16x8, wb); }
    }
    f32x16 o[DV / 32];
#pragma unroll
    for (int i = 0; i < DV / 32; ++i) o[i] = (f32x16){};
    float mrun = -INFINITY, lrun = 0.f, Rrun = 0.f;
    bf16x8 utri[2], uone;
    if (MODE == 2) {
#pragma unroll
        for (int s = 0; s < 2; ++s)
#pragma unroll
            for (int j = 0; j < 8; ++j) { const int key = 16 * s + 8 * (j >> 2) + 4 * hi + (j & 3); utri[s][j] = (short)(key >= r32 ? 0x3F80 : 0); }
#pragma unroll
        for (int j = 0; j < 8; ++j) uone[j] = (short)0x3F80;
    }
    const int NT = 4 * qb + 4;
    v4u kreg[NKL], vreg[NVL]; float ckreg = 0.f;
    const bf16* Kh = Kg + rowbase * pqk + h * DK; const bf16* Vh = Vg + rowbase * pv + h * DV; const float* ckh = (MODE == 1) ? ckg + (size_t)(b * NH + h) * SEQ : nullptr;
#define ATT_LOAD(kt) do { \
        _Pragma("unroll") for (int i = 0; i < NKL; ++i) { const int c = tid + 512 * i, row = c / KCH, cc = c % KCH; kreg[i] = *(const GAS v4u*)(Kh + (size_t)((kt) * 64 + row) * pqk + cc * 8); } \
        _Pragma("unroll") for (int i = 0; i < NVL; ++i) { const int c = tid + 512 * i, row = c / VCH, cc = c % VCH; vreg[i] = *(const GAS v4u*)(Vh + (size_t)((kt) * 64 + row) * pv + cc * 8); } \
        if (MODE == 1 && tid < 64) ckreg = ckh[(kt) * 64 + tid]; } while (0)
#define ATT_STORE(st) do { \
        _Pragma("unroll") for (int i = 0; i < NKL; ++i) { const int c = tid + 512 * i, row = c / KCH, cc = c % KCH; *(LAS v4u*)((st) + row * KST + cc * 16) = kreg[i]; } \
        _Pragma("unroll") for (int i = 0; i < NVL; ++i) { const int c = tid + 512 * i, row = c / VCH, cc = c % VCH; *(LAS v4u*)((st) + KBYTES + row * VST + cc * 16) = vreg[i]; } \
        if (MODE == 1 && tid < 64) *(LAS float*)((st) + KBYTES + VBYTES + tid * 4) = ckreg; } while (0)
    ATT_LOAD(NT - 1); ATT_STORE(lds); __syncthreads();
    const int qrel = wid * 32 + r32;
    for (int it = 0; it < NT; ++it) {
        const int kt = NT - 1 - it; LAS unsigned char* st = lds + (it & 1) * STAGE; LAS unsigned char* stn = lds + ((it & 1) ^ 1) * STAGE;
        if (it + 1 < NT) ATT_LOAD(kt - 1);
        float cknext = 0.f; if (MODE == 1 && it + 1 < NT) cknext = ckh[(kt - 1) * 64 + 63];
        const int jb = kt - 4 * qb;
        if (!(jb >= 0 && 2 * jb > wid)) {
            f32x16 p0 = (f32x16){}, p1 = (f32x16){};
            {
              const LAS unsigned char* kb = st + r32 * KST + hi * 16;
              constexpr int NF = 2 * (DK / 16), FB = 4; bf16x8 kf[2][FB];
#pragma unroll
              for (int i = 0; i < FB; ++i) kf[0][i] = *(const LAS bf16x8*)(kb + (i & 1) * 32 * KST + (i >> 1) * 32);
#pragma unroll
              for (int bq = 0; bq < NF / FB; ++bq) {
                  if (bq + 1 < NF / FB) {
#pragma unroll
                      for (int i = 0; i < FB; ++i) { const int f = (bq + 1) * FB + i; kf[(bq + 1) & 1][i] = *(const LAS bf16x8*)(kb + (f & 1) * 32 * KST + (f >> 1) * 32); } }
                  __builtin_amdgcn_sched_barrier(0); __builtin_amdgcn_s_setprio(1);
#pragma unroll
                  for (int i = 0; i < FB; ++i) { const int f = bq * FB + i;
                      if (f & 1) p1 = __builtin_amdgcn_mfma_f32_32x32x16_bf16(kf[bq & 1][i], qr[f >> 1], p1, 0, 0, 0);
                      else p0 = __builtin_amdgcn_mfma_f32_32x32x16_bf16(kf[bq & 1][i], qr[f >> 1], p0, 0, 0, 0); }
                  __builtin_amdgcn_s_setprio(0); __builtin_amdgcn_sched_barrier(0); } }
            if (MODE != 2) {
                if (MODE == 1) { const LAS float* cks = (const LAS float*)(st + KBYTES + VBYTES);
#pragma unroll
                    for (int g = 0; g < 4; ++g) { const f32x4 c0 = *(const LAS f32x4*)(cks + 8 * g + 4 * hi), c1 = *(const LAS f32x4*)(cks + 32 + 8 * g + 4 * hi);
#pragma unroll
                        for (int i = 0; i < 4; ++i) { p0[4 * g + i] -= c0[i]; p1[4 * g + i] -= c1[i]; } } }
                if (jb >= 0) {
#pragma unroll
                    for (int r = 0; r < 16; ++r) { const int kv = 64 * jb + crow(r, hi); if (kv > qrel) p0[r] = -INFINITY; if (kv + 32 > qrel) p1[r] = -INFINITY; } }
                float mx = p0[0];
#pragma unroll
                for (int r = 1; r < 16; ++r) mx = fmaxf(mx, p0[r]);
#pragma unroll
                for (int r = 0; r < 16; ++r) mx = fmaxf(mx, p1[r]);
                { auto rr = __builtin_amdgcn_permlane32_swap(__float_as_uint(mx), __float_as_uint(mx), false, false); mx = fmaxf(__uint_as_float(rr[0]), __uint_as_float(rr[1])); }
                if (__any(mx - mrun > 8.0f)) { const float mnew = fmaxf(mrun, mx), alpha = __builtin_amdgcn_exp2f(mrun - mnew); mrun = mnew; lrun *= alpha;
#pragma unroll
                    for (int i = 0; i < DV / 32; ++i) o[i] *= alpha; }
                float sum = 0.f;
#pragma unroll
                for (int r = 0; r < 16; ++r) { p0[r] = __builtin_amdgcn_exp2f(p0[r] - mrun); p1[r] = __builtin_amdgcn_exp2f(p1[r] - mrun); sum += p0[r] + p1[r]; }
                lrun += sum;
            } else {
                f32x16 l0, l1;
#pragma unroll
                for (int r = 0; r < 16; ++r) { l0[r] = __builtin_amdgcn_logf(1.0f + __builtin_amdgcn_exp2f(p0[r])); l1[r] = __builtin_amdgcn_logf(1.0f + __builtin_amdgcn_exp2f(p1[r])); }
                if (jb >= 0) {
#pragma unroll
                    for (int r = 0; r < 16; ++r) { const int kv = 64 * jb + crow(r, hi); if (kv >= qrel) l0[r] = 0.f; if (kv + 32 >= qrel) l1[r] = 0.f; } }
                v4u lb[4];
#pragma unroll
                for (int s = 0; s < 2; ++s) { lb[s].x = pg8::cvt_pk_bf16(l0[8 * s], l0[8 * s + 1]); lb[s].y = pg8::cvt_pk_bf16(l0[8 * s + 2], l0[8 * s + 3]); lb[s].z = pg8::cvt_pk_bf16(l0[8 * s + 4], l0[8 * s + 5]); lb[s].w = pg8::cvt_pk_bf16(l0[8 * s + 6], l0[8 * s + 7]);
                    lb[2 + s].x = pg8::cvt_pk_bf16(l1[8 * s], l1[8 * s + 1]); lb[2 + s].y = pg8::cvt_pk_bf16(l1[8 * s + 2], l1[8 * s + 3]); lb[2 + s].z = pg8::cvt_pk_bf16(l1[8 * s + 4], l1[8 * s + 5]); lb[2 + s].w = pg8::cvt_pk_bf16(l1[8 * s + 6], l1[8 * s + 7]); }
                f32x16 c0, c1;
#pragma unroll
                for (int r = 0; r < 16; ++r) { c0[r] = Rrun; c1[r] = Rrun; }
                c0 = __builtin_amdgcn_mfma_f32_32x32x16_bf16(utri[0], __builtin_bit_cast(bf16x8, lb[0]), c0, 0, 0, 0);
                c0 = __builtin_amdgcn_mfma_f32_32x32x16_bf16(utri[1], __builtin_bit_cast(bf16x8, lb[1]), c0, 0, 0, 0);
                c0 = __builtin_amdgcn_mfma_f32_32x32x16_bf16(uone, __builtin_bit_cast(bf16x8, lb[2]), c0, 0, 0, 0);
                c0 = __builtin_amdgcn_mfma_f32_32x32x16_bf16(uone, __builtin_bit_cast(bf16x8, lb[3]), c0, 0, 0, 0);
                c1 = __builtin_amdgcn_mfma_f32_32x32x16_bf16(utri[0], __builtin_bit_cast(bf16x8, lb[2]), c1, 0, 0, 0);
                c1 = __builtin_amdgcn_mfma_f32_32x32x16_bf16(utri[1], __builtin_bit_cast(bf16x8, lb[3]), c1, 0, 0, 0);
#pragma unroll
                for (int r = 0; r < 16; ++r) { p0[r] = __builtin_amdgcn_exp2f(p0[r] - c0[r]); p1[r] = __builtin_amdgcn_exp2f(p1[r] - c1[r]); }
                if (jb >= 0) {
#pragma unroll
                    for (int r = 0; r < 16; ++r) { const int kv = 64 * jb + crow(r, hi); if (kv >= qrel) p0[r] = 0.f; if (kv + 32 >= qrel) p1[r] = 0.f; } }
                { auto rr = __builtin_amdgcn_permlane32_swap(__float_as_uint(c0[0]), __float_as_uint(c0[0]), false, false); Rrun = __uint_as_float(rr[0]); }
            }
            v4u pb[4];
#pragma unroll
            for (int s = 0; s < 2; ++s) { pb[s].x = pg8::cvt_pk_bf16(p0[8 * s], p0[8 * s + 1]); pb[s].y = pg8::cvt_pk_bf16(p0[8 * s + 2], p0[8 * s + 3]); pb[s].z = pg8::cvt_pk_bf16(p0[8 * s + 4], p0[8 * s + 5]); pb[s].w = pg8::cvt_pk_bf16(p0[8 * s + 6], p0[8 * s + 7]);
                pb[2 + s].x = pg8::cvt_pk_bf16(p1[8 * s], p1[8 * s + 1]); pb[2 + s].y = pg8::cvt_pk_bf16(p1[8 * s + 2], p1[8 * s + 3]); pb[2 + s].z = pg8::cvt_pk_bf16(p1[8 * s + 4], p1[8 * s + 5]); pb[2 + s].w = pg8::cvt_pk_bf16(p1[8 * s + 6], p1[8 * s + 7]); }
            {
              const LAS unsigned char* vb = st + KBYTES + (4 * hi + ((lane & 15) >> 2)) * VST + ((lane >> 4) & 1) * 32 + (lane & 3) * 8;
              constexpr int NBLK = DV / 32, NP = NBLK * 4, PB = 4; s16x4 vt[2][PB][2];
#define ATT_VRD(buf, g) do { const LAS unsigned char* vp_ = vb + (16 * ((g) / NBLK)) * VST + ((g) % NBLK) * 64; \
                  vt[buf][(g) % PB][0] = __builtin_bit_cast(s16x4, __builtin_amdgcn_ds_read_tr16_b64_v4i16((LAS s16x4*)vp_)); \
                  vt[buf][(g) % PB][1] = __builtin_bit_cast(s16x4, __builtin_amdgcn_ds_read_tr16_b64_v4i16((LAS s16x4*)(vp_ + 8 * VST))); } while (0)
#pragma unroll
              for (int i = 0; i < PB; ++i) ATT_VRD(0, i);
#pragma unroll
              for (int bq = 0; bq < NP / PB; ++bq) {
                  if (bq + 1 < NP / PB) {
#pragma unroll
                      for (int i = 0; i < PB; ++i) ATT_VRD((bq + 1) & 1, (bq + 1) * PB + i); }
                  __builtin_amdgcn_sched_barrier(0); __builtin_amdgcn_s_setprio(1);
#pragma unroll
                  for (int i = 0; i < PB; ++i) { const int g = bq * PB + i; const s16x4 t0 = vt[bq & 1][i][0], t1 = vt[bq & 1][i][1];
                      const bf16x8 af = (bf16x8){t0[0], t0[1], t0[2], t0[3], t1[0], t1[1], t1[2], t1[3]};
                      o[g % NBLK] = __builtin_amdgcn_mfma_f32_32x32x16_bf16(af, __builtin_bit_cast(bf16x8, pb[g / NBLK]), o[g % NBLK], 0, 0, 0); }
                  __builtin_amdgcn_s_setprio(0); __builtin_amdgcn_sched_barrier(0); }
#undef ATT_VRD
            }
        }
        if (it + 1 < NT) ATT_STORE(stn);
        if (MODE == 2) {
            LAS unsigned* fl = (LAS unsigned*)(lds + RING_BYTES) + (it & 1) * 8;
            const bool wdone = __all(Rrun > 36.0f);
            if (lane == 0) fl[wid] = wdone ? 1u : 0u;
            __syncthreads();
            const v4u f0 = *(const LAS v4u*)fl, f1 = *(const LAS v4u*)(fl + 4);
            if ((f0.x & f0.y & f0.z & f0.w & f1.x & f1.y & f1.z & f1.w) != 0u) break;
        } else if (MODE == 1) {
            LAS unsigned* fl = (LAS unsigned*)(lds + RING_BYTES) + (it & 1) * 8;
            const bool wdone = __all(mrun - (sbound - cknext) > 36.0f);
            if (lane == 0) fl[wid] = wdone ? 1u : 0u;
            __syncthreads();
            const v4u f0 = *(const LAS v4u*)fl, f1 = *(const LAS v4u*)(fl + 4);
            if ((f0.x & f0.y & f0.z & f0.w & f1.x & f1.y & f1.z & f1.w) != 0u) break;
        } else __syncthreads();
    }
#undef ATT_LOAD
#undef ATT_STORE
    float inv = 1.0f;
    if (MODE != 2) { auto rr = __builtin_amdgcn_permlane32_swap(__float_as_uint(lrun), __float_as_uint(lrun), false, false); inv = 1.0f / (__uint_as_float(rr[0]) + __uint_as_float(rr[1])); }
    bf16* op = Og + (rowbase + q0 + wid * 32 + r32) * pv + h * DV + 4 * hi;
#pragma unroll
    for (int blk = 0; blk < DV / 32; ++blk)
#pragma unroll
        for (int g = 0; g < 4; ++g) { v2u w; w.x = pk2(o[blk][4 * g] * inv, o[blk][4 * g + 1] * inv); w.y = pk2(o[blk][4 * g + 2] * inv, o[blk][4 * g + 3] * inv); *(GAS v2u*)(op + 32 * blk + 8 * g) = w; }
}
struct Args { const void* in[25]; float* out; unsigned char* ws; int ph_lo, ph_hi; };
__global__ void __launch_bounds__(NWAVES * 64, 2) mk_fwd(Args args) {
    extern __shared__ __attribute__((aligned(16))) unsigned char lds_raw[];
    LAS unsigned char* lds = (LAS unsigned char*)lds_raw;
    volatile LAS unsigned* MISC = (volatile LAS unsigned*)(lds + MISC_OFF);
    const int G = gridDim.x, bx = blockIdx.x; const int vcu = (G % 8 == 0) ? (bx % 8) * (G / 8) + bx / 8 : bx;
    const int NGW = G * NWAVES, nthr_g = G * NWAVES * 64;
    unsigned char* ws = args.ws; gu32* ctl = (gu32*)(ws + WS_CTL);
    for (int u = threadIdx.x; u < (LDS_BYTES - LDSCTL_OFF) / 4; u += NWAVES * 64) ((LAS unsigned*)(lds + LDSCTL_OFF))[u] = 0u;
    __syncthreads();
    XcdBarrier bar = xcd_barrier_post((unsigned*)(ctl + CW_BAR), MISC + 8);
    const int lo = args.ph_lo, hi = args.ph_hi; int ph = 0;
#define PH_BEGIN if (lo <= ph && ph < hi) { int tid = threadIdx.x; asm volatile("" : "+v"(tid)); const int lane = tid & 63, wave = __builtin_amdgcn_readfirstlane(tid >> 6), gw = vcu * NWAVES + wave, tid_g = vcu * NWAVES * 64 + tid; (void)lane; (void)gw; (void)tid_g;
#define PH_END   if (ph + 1 < hi) xcd_barrier(bar); } ++ph;

#define XN ((bf16*)(ws + WS_XN))
#define CQ ((bf16*)(ws + WS_CQ))
#define CKV ((bf16*)(ws + WS_CKV))
#define QKV6 ((bf16*)(ws + WS_QKV6))
#define GATES ((bf16*)(ws + WS_GATES))
#define QM ((bf16*)(ws + WS_QM))
#define KM ((bf16*)(ws + WS_KM))
#define VM ((bf16*)(ws + WS_VM))
#define KNOPE ((bf16*)(ws + WS_KNOPE))
#define OA ((bf16*)(ws + WS_OA))
#define OB ((bf16*)(ws + WS_OB))
#define OC ((bf16*)(ws + WS_OC))
#define MF ((float*)(ws + WS_MF))
#define MB ((bf16*)(ws + WS_MB))
#define HS ((bf16*)(ws + WS_HS))
#define ACT ((bf16*)(ws + WS_ACT))
#define YB ((bf16*)(ws + WS_Y))
#define SEGS ((size_t)NTOK * 1024)
#define XSRC ((l == 0) ? (const float*)args.in[0] : (const float*)(ws + WS_XB))
#define XO (args.out)
#define POSITIONS ((const int*)args.in[1])

#pragma unroll 1
    for (int l = 0; l < DEPTH; ++l) {
        PH_BEGIN
            if (l == 0) {
                for (int l2 = 0; l2 < DEPTH; ++l2)
                    phase_convert_small((const float*)args.in[3] + (size_t)l2 * 2048 * DIN, (const float*)args.in[20] + (size_t)l2 * 2048 * 8, (const float*)args.in[21] + (size_t)l2 * 2048 * 64,
                                        (bf16*)(ws + WS_WSK) + (size_t)l2 * 80 * 2048, (bf16*)(ws + WS_WRT) + (size_t)l2 * 80 * 2048, tid_g, nthr_g);
                phase_rope(ws, POSITIONS, tid_g, nthr_g);
                if (tid_g < DEPTH * 256) { const int l2 = tid_g >> 8, wh = (tid_g >> 6) & 3, d = tid_g & 63;
                    ((float*)(ws + WS_GN))[tid_g] = ((const float*)args.in[10 + wh])[l2 * 64 + d]; }
            }
            ConvSrc S; S.w_in = (const float*)args.in[3] + (size_t)l * 2048 * DIN; S.w_uq = (const float*)args.in[5] + (size_t)l * 512 * 3072; S.w_ukv = (const float*)args.in[7] + (size_t)l * 512 * 4096;
            S.w_ba = (const float*)args.in[15] + (size_t)l * 2048 * 2048; S.w_bb = (const float*)args.in[16] + (size_t)l * 1024 * 2048; S.w_bc = (const float*)args.in[17] + (size_t)l * 1024 * 2048;
            S.w_out = (const float*)args.in[18] + (size_t)l * 2048 * 2048; S.g_cq = (const float*)args.in[4] + l * 512; S.g_ckv = (const float*)args.in[6] + l * 512;
            S.w_eg = (const float*)args.in[22] + (size_t)l * 64 * 2048 * 512; S.w_eu = (const float*)args.in[23] + (size_t)l * 64 * 2048 * 512; S.w_ed = (const float*)args.in[24] + (size_t)l * 64 * 512 * 2048;
            phase_convert(S, ws, gw, NGW, 7552, lane, lds + 65536 + wave * 9216);
            if (l == 0) xcd_barrier(bar);
            else { asm volatile("s_waitcnt vmcnt(0)" ::: "memory"); __syncthreads(); }
            if (l == 0) phase_norm_skinny<false, false>((const float*)args.in[0], nullptr, nullptr, nullptr, (const float*)args.in[2], (const bf16*)(ws + WS_WSK), XN, (float*)(ws + WS_RS), (float*)(ws + WS_SK), nullptr, nullptr, nullptr, nullptr, lds, gw, NGW, wave, lane, (const float*)args.in[9] + l * 192 + 128, (const float*)(ws + WS_ROPE), (float*)(ws + WS_KNOPE));
            if (l != 0) phase_norm_skinny<true, false>(XO, (float*)(ws + WS_XB), YB, (const int*)(ws + WS_ASG) + 3 * NASG, (const float*)args.in[2] + l * DM, (const bf16*)(ws + WS_WSK) + (size_t)l * 80 * 2048, XN, (float*)(ws + WS_RS), (float*)(ws + WS_SK), nullptr, nullptr, nullptr, nullptr, lds, gw, NGW, wave, lane, (const float*)args.in[9] + l * 192 + 128, (const float*)(ws + WS_ROPE), (float*)(ws + WS_KNOPE));
        PH_END
        PH_BEGIN
            phase_cumsum(ws, (const float*)args.in[14] + l * 16, lds, vcu, G, tid, lane);
            { pg8::Gemm g{XN, (const bf16*)(ws + WS_WIN), NTOK, NBIG, DM}; pg8::StaticOrder S; S.init(NTOK, NBIG, G, bx);
              pg8::EpiSeg E{ws, (const float*)(ws + WS_GN) + l * 256};
              pg8::gemm_phase<pg8::EpiSeg, pg8::StaticOrder, true, true>(lds + RING_OFF, g, S, E); }
        PH_END
        PH_BEGIN
            { pg8::Gemm g{CQ, (const bf16*)(ws + WS_WUQ), NTOK, 3072, 512}; pg8::StaticOrder S; S.init(NTOK, 3072, G, bx); pg8::EpiPlain E{QM, 3072};
              pg8::gemm_phase<pg8::EpiPlain, pg8::StaticOrder, true, true>(lds + RING_OFF, g, S, E); }
            { pg8::Gemm g{CKV, (const bf16*)(ws + WS_WUKV), NTOK, 4096, 512}; pg8::StaticOrder S; S.init(NTOK, 4096, G, bx); pg8::EpiKF E{KM, VM, (const float*)(ws + WS_PART), (const float*)(ws + WS_KNOPE), (const float*)(ws + WS_SK), (const float*)args.in[9] + l * 192, (unsigned)(size_t)(lds + RING_BYTES + 2048)};
              pg8::gemm_phase<pg8::EpiKF, pg8::StaticOrder, true, true>(lds + RING_OFF, g, S, E); }
        PH_END
        PH_BEGIN
            { LAS unsigned* slot = (LAS unsigned*)(lds + RING_BYTES + 64);
#define ATT_QUEUE(QI, CALL) for (int dq_ = 0; dq_ < 8; ++dq_) { const int xq_ = (int)((bar.x + (unsigned)dq_) & 7u); \
                gu32* q_ = ctl + CW_AQ + ((l * 3 + (QI)) * 8 + xq_) * 64; \
                if (threadIdx.x == 0) *slot = __hip_atomic_fetch_add(q_, 1u, __ATOMIC_RELAXED, __HIP_MEMORY_SCOPE_AGENT); \
                __syncthreads(); unsigned cur = (unsigned)__builtin_amdgcn_readfirstlane((int)*slot); __syncthreads(); \
                while (cur < 128u) { unsigned nxt_ = 0u; if (threadIdx.x == 0) nxt_ = __hip_atomic_fetch_add(q_, 1u, __ATOMIC_RELAXED, __HIP_MEMORY_SCOPE_AGENT); \
                    const int qb = 15 - (int)((cur & 31u) >> 1), bh = (int)(2u * (cur >> 5) + (cur & 1u)) * 8 + xq_, b = bh >> 4, h = bh & 15; \
                    CALL; \
                    if (threadIdx.x == 0) *slot = nxt_; \
                    __syncthreads(); cur = (unsigned)__builtin_amdgcn_readfirstlane((int)*slot); __syncthreads(); } }
              for (int dq_ = 0; dq_ < 8; ++dq_) { const int xq_ = (int)((bar.x + (unsigned)dq_) & 7u);
                gu32* q_ = ctl + CW_AQ + ((l * 3 + 0) * 8 + xq_) * 64;
                if (threadIdx.x == 0) *slot = __hip_atomic_fetch_add(q_, 1u, __ATOMIC_RELAXED, __HIP_MEMORY_SCOPE_AGENT);
                __syncthreads(); unsigned cur = (unsigned)__builtin_amdgcn_readfirstlane((int)*slot); __syncthreads();
                while (cur < 176u) { unsigned nxt_ = 0u; if (threadIdx.x == 0) nxt_ = __hip_atomic_fetch_add(q_, 1u, __ATOMIC_RELAXED, __HIP_MEMORY_SCOPE_AGENT);
                    const unsigned grp = cur / 11u, pos = cur - grp * 11u;
                    if (pos == 3u || pos == 7u || pos == 10u) {
                        const int chunk = xq_ * 48 + (int)grp * 3 + (pos == 3u ? 0 : (pos == 7u ? 1 : 2));
                        conv_expert_items((const float*)args.in[22] + (size_t)l * 64 * 2048 * 512, (const float*)args.in[23] + (size_t)l * 64 * 2048 * 512, (const float*)args.in[24] + (size_t)l * 64 * 512 * 2048,
                                          (const float*)args.in[15] + (size_t)l * 2048 * 2048, (const float*)args.in[16] + (size_t)l * 1024 * 2048, (const float*)args.in[17] + (size_t)l * 1024 * 2048, (const float*)args.in[18] + (size_t)l * 2048 * 2048,
                                          ws, chunk * 128 + wave, chunk * 8 + wave, lds + 65536 + wave * 9216);
                    } else {
                        const unsigned u = grp * 8u + pos - (pos > 3u ? 1u : 0u) - (pos > 7u ? 1u : 0u);
                        const int qb = 15 - (int)((u & 31u) >> 1), bh = (int)(2u * (u >> 5) + (u & 1u)) * 8 + xq_, b = bh >> 4, h = bh & 15;
                        attn_unit<192, 128, 0>(lds, QM, KM, VM, OA, 3072, 2048, b, h, qb, nullptr, 0.f, (const float*)args.in[8] + l * 192, (const float*)(ws + WS_ROPE));
                    }
                    if (threadIdx.x == 0) *slot = nxt_;
                    __syncthreads(); cur = (unsigned)__builtin_amdgcn_readfirstlane((int)*slot); __syncthreads(); } }
              float fox_bound; { int t2_ = threadIdx.x; asm volatile("" : "+v"(t2_)); const int ln2 = t2_ & 63; const float gq = fabsf(((const float*)args.in[12])[l * 64 + ln2]), gk = fabsf(((const float*)args.in[13])[l * 64 + ln2]); float mq = gq, mk = gk;
#pragma unroll
                for (int o = 1; o < 64; o <<= 1) { mq = fmaxf(mq, bperm_xor(mq, o, ln2)); mk = fmaxf(mk, bperm_xor(mk, o, ln2)); }
                fox_bound = 8.0f * LOG2E * mq * mk * 1.03f; }
              ATT_QUEUE(1, (attn_unit<64, 64, 1>(lds, QKV6 + 3 * SEGS, QKV6 + 4 * SEGS, QKV6 + 5 * SEGS, OC, 1024, 1024, b, h, qb, (const float*)(ws + WS_CUMF), fox_bound)));
              ATT_QUEUE(2, (attn_unit<64, 64, 2>(lds, QKV6, QKV6 + SEGS, QKV6 + 2 * SEGS, OB, 1024, 1024, b, h, qb, nullptr, 0.f)));
#undef ATT_QUEUE
            }
        PH_END
        PH_BEGIN
            { pg8::Gemm g{OA, (const bf16*)(ws + WS_WBA), NTOK, DM, 2048}; pg8::StaticOrder S; S.init(NTOK, DM, G, bx); pg8::EpiMerge<0> E{GATES, MB};
              pg8::gemm_phase<pg8::EpiMerge<0>, pg8::StaticOrder, true, true>(lds + RING_OFF, g, S, E); }
            { pg8::Gemm g{OB, (const bf16*)(ws + WS_WBB), NTOK, DM, 1024}; pg8::StaticOrder S; S.init(NTOK, DM, G, bx); pg8::EpiMerge<1> E{GATES + 2048, MB};
              pg8::gemm_phase<pg8::EpiMerge<1>, pg8::StaticOrder, true, true>(lds + RING_OFF, g, S, E); }
            { pg8::Gemm g{OC, (const bf16*)(ws + WS_WBC), NTOK, DM, 1024}; pg8::StaticOrder S; S.init(NTOK, DM, G, bx); pg8::EpiMerge<2> E{GATES + 4096, MB};
              pg8::gemm_phase<pg8::EpiMerge<2>, pg8::StaticOrder, true, true>(lds + RING_OFF, g, S, E); }
        PH_END
        PH_BEGIN
            { pg8::Gemm g{MB, (const bf16*)(ws + WS_WOUT), NTOK, DM, 2048}; pg8::StaticOrder S; S.init(NTOK, DM, G, bx); pg8::EpiResid E{XSRC, XO};
              pg8::gemm_phase<pg8::EpiResid, pg8::StaticOrder, true, true>(lds + RING_OFF, g, S, E); }
        PH_END
        PH_BEGIN
            { int* asg_e = (int*)(ws + WS_ASG);
              phase_norm_skinny<false, true>(XO, nullptr, nullptr, nullptr, (const float*)args.in[19] + l * DM, (const bf16*)(ws + WS_WRT) + (size_t)l * 80 * 2048, XN, (float*)(ws + WS_RS2), nullptr,
                                             (unsigned*)(ctl + CW_CNT + 64 * l), asg_e, asg_e + NASG, (float*)(asg_e + 2 * NASG), lds, gw, NGW, wave, lane); }
        PH_END
        PH_BEGIN
            phase_dispatch(ws, (const unsigned*)(ctl + CW_CNT + 64 * l), lds, gw, NGW, tid, lane, bx);
        PH_END
        PH_BEGIN
            { pg8::Gemm g{HS, (const bf16*)(ws + WS_WGU), MAXSLOT, NEXP * 1024, 2048}; pg8::MoeOrder S{(const int*)(ws + WS_TAB), 4, G, bx}; pg8::EpiSwiglu E{ACT, (const float*)(ws + WS_ASG) + 4 * NASG + MAXSLOT};
              pg8::gemm_phase<pg8::EpiSwiglu, pg8::MoeOrder, true, true>(lds + RING_OFF, g, S, E); }
        PH_END
        PH_BEGIN
            { pg8::Gemm g{ACT, (const bf16*)(ws + WS_WD), MAXSLOT, NEXP * 2048, 512}; pg8::MoeOrder S{(const int*)(ws + WS_TAB), 8, G, bx}; pg8::EpiDown E{YB, (const float*)(ws + WS_ASG) + 4 * NASG};
              pg8::gemm_phase<pg8::EpiDown, pg8::MoeOrder, true, true>(lds + RING_OFF, g, S, E); }
        PH_END
    }
    PH_BEGIN
        phase_combine(ws, XO, gw, NGW, lane);
    PH_END
#undef PH_BEGIN
#undef PH_END
}
constexpr int N_PHASES = 1 + 10 * DEPTH;

extern "C" void kernel_launch(void* const* d_in, const int* in_sizes, int n_in, void* d_out, int out_size, void* d_ws, size_t ws_size, hipStream_t stream) {
    static int grid = 0;
    if (grid == 0) {
        if (n_in != 25 || out_size != NTOK * DM || ws_size < WS_END) { fprintf(stderr, "kernel_launch: unexpected shapes (n_in %d out %d ws %zu need %zu); nothing launched\n", n_in, out_size, ws_size, (size_t)WS_END); grid = -1; return; }
        int dev = 0, cus = 0, per_cu = 0;
        if (hipGetDevice(&dev) != hipSuccess || hipDeviceGetAttribute(&cus, hipDeviceAttributeMultiprocessorCount, dev) != hipSuccess) { grid = -1; return; }
        if (hipFuncSetAttribute((const void*)mk_fwd, hipFuncAttributeMaxDynamicSharedMemorySize, LDS_BYTES) != hipSuccess) { fprintf(stderr, "kernel_launch: hipFuncSetAttribute failed\n"); grid = -1; return; }
        if (hipOccupancyMaxActiveBlocksPerMultiprocessor(&per_cu, (const void*)mk_fwd, NWAVES * 64, LDS_BYTES) != hipSuccess || per_cu < 1) { fprintf(stderr, "kernel_launch: occupancy query says %d blocks per CU\n", per_cu); }
        (void)hipGetLastError();
        grid = cus;
    }
    if (grid < 0) return;
    if (hipMemsetAsync((char*)d_ws + WS_CTL, 0, CTL_ZERO_BYTES, stream) != hipSuccess) { fprintf(stderr, "kernel_launch: memset failed\n"); return; }
    Args a{};
    for (int i = 0; i < 25; ++i) a.in[i] = d_in[i];
    a.out = (float*)d_out; a.ws = (unsigned char*)d_ws; a.ph_lo = 0; a.ph_hi = N_PHASES;
    hipLaunchKernelGGL(mk_fwd, dim3(grid), dim3(NWAVES * 64), LDS_BYTES, stream, a);
    const hipError_t le = hipPeekAtLastError();
    if (le != hipSuccess) fprintf(stderr, "kernel_launch: launch failed: %s\n", hipGetErrorName(le));
}
```

```cpp
#include <hip/hip_runtime.h>
#include <cstdio>
#include <cstdint>
#include <cmath>
namespace pg8 {
#define PG8_LAS __attribute__((address_space(3)))
typedef unsigned short bf16_t;
typedef short bf16x8 __attribute__((ext_vector_type(8)));
typedef float f32x4 __attribute__((ext_vector_type(4)));
typedef unsigned u32x4 __attribute__((ext_vector_type(4)));
constexpr int BM = 256, BK = 64, HALF = 128, HTB = HALF * BK * 2  , STAGE_BYTES = 8 * HTB, NXCD = 8, WGM = 4;

__host__ __device__ __forceinline__ int lds_byte(int r, int c) { const int st = (r >> 4) * 2 + (c >> 5), rr = r & 15, cc = c & 31, ob = rr * 64 + cc * 2; return st * 1024 + (ob ^ (((ob >> 9) & 1) << 5)); }
__host__ __device__ __forceinline__ void stage_rc(int b, int& R, int& C) { const int st = b / 1024, sb = b % 1024, swz = sb ^ (((sb >> 9) & 1) << 5); R = (st >> 1) * 16 + swz / 64; C = (st & 1) * 32 + (swz % 64) / 2; }
__host__ __device__ __forceinline__ int perm32(int rho) { const int n = rho >> 4, i = rho & 15; return 8 * (i >> 2) + 4 * n + (i & 3); }

struct Unit { int pm, pn; };
struct Gemm { const bf16_t* A; const bf16_t* Bt; int M, N, K; };

struct StaticOrder {
    int nM, nN, nwg, G, c, wgm;
    __host__ __device__ void init(int M, int N, int G_, int c_, int wgm_ = WGM) { nM = M / BM; nN = N / BM; nwg = nM * nN; G = G_; c = c_; wgm = wgm_; }
    __host__ __device__ bool next(int i, Unit& u) const {
        const long L = (long)i * G + c; if (L >= nwg) return false;
        int wgid = (int)L; { const int q = nwg / NXCD, r = nwg % NXCD, xcd = wgid % NXCD, off = wgid / NXCD; wgid = (xcd < r ? xcd * (q + 1) : r * (q + 1) + (xcd - r) * q) + off; }
        const int nig = wgm * nN, gid = wgid / nig, fm = gid * wgm, gsz = (nM - fm) < wgm ? (nM - fm) : wgm;
        u.pm = fm + ((wgid % nig) % gsz); u.pn = (wgid % nig) / gsz; return true;
    }
    __device__ __forceinline__ void a_ready(const Unit&) const {}
    __device__ __forceinline__ void done(const Unit&) const {}
};
__device__ __forceinline__ unsigned cvt_pk_bf16(float lo, float hi) { unsigned r; asm volatile("v_cvt_pk_bf16_f32 %0, %1, %2" : "=v"(r) : "v"(lo), "v"(hi)); return r; }
typedef float f32x2 __attribute__((ext_vector_type(2)));
typedef unsigned u32x2 __attribute__((ext_vector_type(2)));
__device__ __forceinline__ float bf2f(unsigned short b) { return __uint_as_float(((unsigned)b) << 16); }
__device__ __forceinline__ float bperm_xor(float v, int mask, int lane) { return __int_as_float(__builtin_amdgcn_ds_bpermute((lane ^ mask) << 2, __float_as_int(v))); }
__device__ __forceinline__ float sigmoidf_fast(float x) { return __builtin_amdgcn_rcpf(1.0f + __builtin_amdgcn_exp2f(-1.4426950408889634f * x)); }

struct EpiSeg {
    static constexpr bool PERM = true, AFTER_DRAIN = false;
    unsigned char* ws; const float* gn;
    static constexpr size_t O_CQ = 536ull << 20, O_CKV = 552ull << 20, O_QKV6 = 568ull << 20, O_GATES = 760ull << 20, O_PART = (1ull << 20) + 65536, O_RS = (1ull << 20) + 655360, SEG_BYTES = 16384ull * 1024 * 2;
    __device__ __forceinline__ void operator()(const f32x4 (&acc)[2][2][4][2], const Unit& u, int wr, int wc, int fr, int fq) const {
        const int pn = u.pn; bf16_t* base; int ldc, colt, kind = 0, gsel = 0;
        if (pn < 2) { base = (bf16_t*)(ws + O_CQ); ldc = 512; colt = 256 * pn; }
        else if (pn < 4) { base = (bf16_t*)(ws + O_CKV); ldc = 512; colt = 256 * (pn - 2); kind = 1; }
        else if (pn < 28) { const int s = (pn - 4) >> 2; base = (bf16_t*)(ws + O_QKV6 + (size_t)s * SEG_BYTES); ldc = 1024; colt = 256 * ((pn - 4) & 3);
            if (s != 2 && s != 5) { kind = 2; gsel = (s & 1) + (s >= 3 ? 2 : 0); } }
        else { base = (bf16_t*)(ws + O_GATES); ldc = 6144; colt = 256 * (pn - 28); }
        const int row0 = u.pm * BM + wr * 64 + fr;
        if (kind != 2) {
            const int col0 = colt + wc * 32 + 8 * fq;
#pragma unroll
            for (int ai = 0; ai < 2; ++ai) {
                float rs[4];
#pragma unroll
                for (int m = 0; m < 4; ++m) rs[m] = ((const float*)(ws + O_RS))[row0 + ai * HALF + m * 16];
                __builtin_amdgcn_sched_barrier(0);
#pragma unroll
                for (int m = 0; m < 4; ++m) { bf16_t* rowp = base + (size_t)(row0 + ai * HALF + m * 16) * ldc + col0;
#pragma unroll
                    for (int bj = 0; bj < 2; ++bj) { const f32x4 v0 = acc[ai][bj][m][0] * rs[m], v1 = acc[ai][bj][m][1] * rs[m];
                        u32x4 w; w.x = cvt_pk_bf16(v0[0], v0[1]); w.y = cvt_pk_bf16(v0[2], v0[3]); w.z = cvt_pk_bf16(v1[0], v1[1]); w.w = cvt_pk_bf16(v1[2], v1[3]);
                        *(u32x4*)(rowp + bj * HALF) = w; } }
                if (kind == 1) {
                    float* part = (float*)(ws + O_PART);
#pragma unroll
                    for (int m = 0; m < 4; ++m) { float s = 0.f;
#pragma unroll
                        for (int bj = 0; bj < 2; ++bj)
#pragma unroll
                            for (int n = 0; n < 2; ++n) { const f32x4 x = acc[ai][bj][m][n] * rs[m]; s += (x[0] * x[0] + x[1] * x[1]) + (x[2] * x[2] + x[3] * x[3]); }
                        { const int ln_ = fr | (fq << 4); s += bperm_xor(s, 16, ln_); s += bperm_xor(s, 32, ln_); }
                        if (fq == 0) part[(size_t)(row0 + ai * HALF + m * 16) * 8 + (pn - 2) * 4 + wc] = s; } }
                __builtin_amdgcn_sched_barrier(0); }
        } else {
            const float* g = gn + gsel * 64 + 8 * fq; const f32x4 ga0 = *(const f32x4*)g, ga1 = *(const f32x4*)(g + 4), gb0 = *(const f32x4*)(g + 32), gb1 = *(const f32x4*)(g + 36);
            const float qs = (gsel & 1) ? 1.0f : 0.125f * 1.4426950408889634f;
            const int col0 = colt + wc * 64 + 8 * fq;
#pragma unroll
            for (int ai = 0; ai < 2; ++ai)
#pragma unroll
                for (int m = 0; m < 4; ++m) { float s = 0.f;
#pragma unroll
                    for (int bj = 0; bj < 2; ++bj)
#pragma unroll
                        for (int n = 0; n < 2; ++n) { const f32x4 x = acc[ai][bj][m][n]; s += (x[0] * x[0] + x[1] * x[1]) + (x[2] * x[2] + x[3] * x[3]); }
                    { const int ln_ = fr | (fq << 4); s += bperm_xor(s, 16, ln_); s += bperm_xor(s, 32, ln_); }
                    const float r = qs * __builtin_amdgcn_rsqf(s * (1.0f / 64.f) + 1e-6f);
                    bf16_t* rowp = base + (size_t)(row0 + ai * HALF + m * 16) * ldc + col0;
                    { const f32x4 v0 = acc[ai][0][m][0] * ga0 * r, v1 = acc[ai][0][m][1] * ga1 * r;
                      u32x4 w; w.x = cvt_pk_bf16(v0[0], v0[1]); w.y = cvt_pk_bf16(v0[2], v0[3]); w.z = cvt_pk_bf16(v1[0], v1[1]); w.w = cvt_pk_bf16(v1[2], v1[3]); *(u32x4*)rowp = w; }
                    { const f32x4 v0 = acc[ai][1][m][0] * gb0 * r, v1 = acc[ai][1][m][1] * gb1 * r;
                      u32x4 w; w.x = cvt_pk_bf16(v0[0], v0[1]); w.y = cvt_pk_bf16(v0[2], v0[3]); w.z = cvt_pk_bf16(v1[0], v1[1]); w.w = cvt_pk_bf16(v1[2], v1[3]); *(u32x4*)(rowp + 32) = w; } }
        }
    }
};
struct EpiPlain {
    static constexpr bool PERM = true, AFTER_DRAIN = false;
    bf16_t* O; int ldc;
    __device__ __forceinline__ void operator()(const f32x4 (&acc)[2][2][4][2], const Unit& u, int wr, int wc, int fr, int fq) const {
        const int row0 = u.pm * BM + wr * 64 + fr, col0 = u.pn * BM + wc * 32 + 8 * fq;
#pragma unroll
        for (int ai = 0; ai < 2; ++ai)
#pragma unroll
            for (int m = 0; m < 4; ++m) { bf16_t* rowp = O + (size_t)(row0 + ai * HALF + m * 16) * ldc + col0;
#pragma unroll
                for (int bj = 0; bj < 2; ++bj) { const f32x4 v0 = acc[ai][bj][m][0], v1 = acc[ai][bj][m][1];
                    u32x4 w; w.x = cvt_pk_bf16(v0[0], v0[1]); w.y = cvt_pk_bf16(v0[2], v0[3]); w.z = cvt_pk_bf16(v1[0], v1[1]); w.w = cvt_pk_bf16(v1[2], v1[3]);
                    *(u32x4*)(rowp + bj * HALF) = w; } }
    }
};
struct EpiKV {
    static constexpr bool PERM = true, AFTER_DRAIN = false;
    bf16_t* KN; bf16_t* V; const float* part;
    __device__ __forceinline__ void operator()(const f32x4 (&acc)[2][2][4][2], const Unit& u, int wr, int wc, int fr, int fq) const {
        const int row0 = u.pm * BM + wr * 64 + fr, col0 = u.pn * 128 + wc * 32 + 8 * fq;
        f32x4 pav[2][4], pbv[2][4];
#pragma unroll
        for (int ai = 0; ai < 2; ++ai)
#pragma unroll
            for (int m = 0; m < 4; ++m) { const int rw = row0 + ai * HALF + m * 16; pav[ai][m] = *(const f32x4*)(part + (size_t)rw * 8); pbv[ai][m] = *(const f32x4*)(part + (size_t)rw * 8 + 4); }
        __builtin_amdgcn_sched_barrier(0);
#pragma unroll
        for (int ai = 0; ai < 2; ++ai)
#pragma unroll
            for (int m = 0; m < 4; ++m) { const int rw = row0 + ai * HALF + m * 16; const size_t off = (size_t)rw * 2048 + col0;
                const f32x4 pa = pav[ai][m], pb = pbv[ai][m];
                const float ssq = ((pa[0] + pa[1]) + (pa[2] + pa[3])) + ((pb[0] + pb[1]) + (pb[2] + pb[3]));
                const float r = __builtin_amdgcn_rsqf(ssq * (1.0f / 512.f) + 1e-6f);
#pragma unroll
                for (int bj = 0; bj < 2; ++bj) { const f32x4 v0 = acc[ai][bj][m][0] * r, v1 = acc[ai][bj][m][1] * r;
                    u32x4 w; w.x = cvt_pk_bf16(v0[0], v0[1]); w.y = cvt_pk_bf16(v0[2], v0[3]); w.z = cvt_pk_bf16(v1[0], v1[1]); w.w = cvt_pk_bf16(v1[2], v1[3]);
                    *(u32x4*)((bj == 0 ? KN : V) + off) = w; } }
    }
};
struct EpiKF {
    static constexpr bool PERM = true, AFTER_DRAIN = false;
    bf16_t* K; bf16_t* V; const float* part; const float* ssr; const float* kr; const float* gk; unsigned xch;
    __device__ __forceinline__ void operator()(const f32x4 (&acc)[2][2][4][2], const Unit& u, int wr, int wc, int fr, int fq) const {
        const int row0 = u.pm * BM + wr * 64 + fr, lane = fq * 16 + fr;
        PG8_LAS float* X = (PG8_LAS float*)(size_t)xch;
        float rc[2][4];
        { f32x4 pav[2][4], pbv[2][4];
#pragma unroll
          for (int ai = 0; ai < 2; ++ai)
#pragma unroll
            for (int m = 0; m < 4; ++m) { const int rw = row0 + ai * HALF + m * 16; pav[ai][m] = *(const f32x4*)(part + (size_t)rw * 8); pbv[ai][m] = *(const f32x4*)(part + (size_t)rw * 8 + 4); }
          __builtin_amdgcn_sched_barrier(0);
#pragma unroll
          for (int ai = 0; ai < 2; ++ai)
#pragma unroll
            for (int m = 0; m < 4; ++m) { const f32x4 pa = pav[ai][m], pb = pbv[ai][m];
                const float r = __builtin_amdgcn_rsqf((((pa[0] + pa[1]) + (pa[2] + pa[3])) + ((pb[0] + pb[1]) + (pb[2] + pb[3]))) * (1.0f / 512.f) + 1e-6f); rc[ai][m] = r;
                const f32x4 v0 = acc[ai][0][m][0] * r, v1 = acc[ai][0][m][1] * r;
                float s = ((v0[0] * v0[0] + v0[1] * v0[1]) + (v0[2] * v0[2] + v0[3] * v0[3])) + ((v1[0] * v1[0] + v1[1] * v1[1]) + (v1[2] * v1[2] + v1[3] * v1[3]));
                s += bperm_xor(s, 16, lane); s += bperm_xor(s, 32, lane);
                if (fq == 0) X[(ai * HALF + wr * 64 + m * 16 + fr) * 4 + wc] = s; } }
        const f32x4 g0 = *(const f32x4*)(gk + wc * 32 + 8 * fq), g1 = *(const f32x4*)(gk + wc * 32 + 8 * fq + 4);
        float sr[2][4]; f32x4 kq[2][4];
#pragma unroll
        for (int ai = 0; ai < 2; ++ai)
#pragma unroll
            for (int m = 0; m < 4; ++m) { const int rw = row0 + ai * HALF + m * 16; sr[ai][m] = ssr[rw]; kq[ai][m] = *(const f32x4*)(kr + (size_t)rw * 80 + 16 * wc + 4 * fq); }
        __builtin_amdgcn_sched_barrier(0);
        asm volatile("s_waitcnt lgkmcnt(0)" ::: "memory"); __builtin_amdgcn_s_barrier();
#pragma unroll
        for (int ai = 0; ai < 2; ++ai)
#pragma unroll
            for (int m = 0; m < 4; ++m) { const int rw = row0 + ai * HALF + m * 16; const float r = rc[ai][m];
                const f32x4 p = *(const PG8_LAS f32x4*)(X + (ai * HALF + wr * 64 + m * 16 + fr) * 4);
                const float rn = __builtin_amdgcn_rsqf((((p[0] + p[1]) + (p[2] + p[3])) + sr[ai][m]) * (1.0f / 192.f) + 1e-6f), rk = r * rn;
                { const f32x4 v0 = acc[ai][0][m][0] * rk * g0, v1 = acc[ai][0][m][1] * rk * g1;
                  u32x4 w; w.x = cvt_pk_bf16(v0[0], v0[1]); w.y = cvt_pk_bf16(v0[2], v0[3]); w.z = cvt_pk_bf16(v1[0], v1[1]); w.w = cvt_pk_bf16(v1[2], v1[3]);
                  *(u32x4*)(K + (size_t)rw * 3072 + u.pn * 192 + wc * 32 + 8 * fq) = w; }
                { const f32x4 v0 = acc[ai][1][m][0] * r, v1 = acc[ai][1][m][1] * r;
                  u32x4 w; w.x = cvt_pk_bf16(v0[0], v0[1]); w.y = cvt_pk_bf16(v0[2], v0[3]); w.z = cvt_pk_bf16(v1[0], v1[1]); w.w = cvt_pk_bf16(v1[2], v1[3]);
                  *(u32x4*)(V + (size_t)rw * 2048 + u.pn * 128 + wc * 32 + 8 * fq) = w; }
                { const f32x4 q = kq[ai][m] * rn;
                  u32x2 w; w.x = cvt_pk_bf16(q[0], q[1]); w.y = cvt_pk_bf16(q[2], q[3]);
                  *(u32x2*)(K + (size_t)rw * 3072 + u.pn * 192 + 128 + 16 * wc + 4 * fq) = w; } }
    }
};
template <int MODE> struct EpiMerge {
    static constexpr bool PERM = true, AFTER_DRAIN = false;
    const bf16_t* gate; bf16_t* Mb;
    __device__ __forceinline__ void operator()(const f32x4 (&acc)[2][2][4][2], const Unit& u, int wr, int wc, int fr, int fq) const {
        const int row0 = u.pm * BM + wr * 64 + fr, col0 = u.pn * BM + wc * 32 + 8 * fq;
#pragma unroll
        for (int ai = 0; ai < 2; ++ai) {
            u32x4 gw[4][2], mw[4][2];
#pragma unroll
            for (int m = 0; m < 4; ++m)
#pragma unroll
                for (int bj = 0; bj < 2; ++bj) { const size_t r = (size_t)(row0 + ai * HALF + m * 16); const int c = col0 + bj * HALF;
                    gw[m][bj] = *(const u32x4*)(gate + r * 6144 + c); if (MODE >= 1) mw[m][bj] = *(const u32x4*)(Mb + r * 2048 + c); }
            __builtin_amdgcn_sched_barrier(0);
#pragma unroll
            for (int m = 0; m < 4; ++m)
#pragma unroll
                for (int bj = 0; bj < 2; ++bj) { const size_t r = (size_t)(row0 + ai * HALF + m * 16); const int c = col0 + bj * HALF; const u32x4 g_ = gw[m][bj];
                    f32x4 g0, g1; g0[0] = sigmoidf_fast(__uint_as_float(g_.x << 16)); g0[1] = sigmoidf_fast(__uint_as_float(g_.x & 0xffff0000u)); g0[2] = sigmoidf_fast(__uint_as_float(g_.y << 16)); g0[3] = sigmoidf_fast(__uint_as_float(g_.y & 0xffff0000u));
                    g1[0] = sigmoidf_fast(__uint_as_float(g_.z << 16)); g1[1] = sigmoidf_fast(__uint_as_float(g_.z & 0xffff0000u)); g1[2] = sigmoidf_fast(__uint_as_float(g_.w << 16)); g1[3] = sigmoidf_fast(__uint_as_float(g_.w & 0xffff0000u));
                    f32x4 v0 = g0 * acc[ai][bj][m][0], v1 = g1 * acc[ai][bj][m][1];
                    if (MODE >= 1) { const u32x4 q = mw[m][bj];
                        v0[0] += __uint_as_float(q.x << 16); v0[1] += __uint_as_float(q.x & 0xffff0000u); v0[2] += __uint_as_float(q.y << 16); v0[3] += __uint_as_float(q.y & 0xffff0000u);
                        v1[0] += __uint_as_float(q.z << 16); v1[1] += __uint_as_float(q.z & 0xffff0000u); v1[2] += __uint_as_float(q.w << 16); v1[3] += __uint_as_float(q.w & 0xffff0000u); }
                    u32x4 w; w.x = cvt_pk_bf16(v0[0], v0[1]); w.y = cvt_pk_bf16(v0[2], v0[3]); w.z = cvt_pk_bf16(v1[0], v1[1]); w.w = cvt_pk_bf16(v1[2], v1[3]);
                    *(u32x4*)(Mb + r * 2048 + c) = w; }
            __builtin_amdgcn_sched_barrier(0); }
    }
};
template <bool SRCBF> struct EpiResidB {
    static constexpr bool PERM = true, AFTER_DRAIN = false;
    const void* xin; bf16_t* xout;
    __device__ __forceinline__ void operator()(const f32x4 (&acc)[2][2][4][2], const Unit& u, int wr, int wc, int fr, int fq) const {
        const int row0 = u.pm * BM + wr * 64 + fr, col0 = u.pn * BM + wc * 32 + 8 * fq;
#pragma unroll
        for (int ai = 0; ai < 2; ++ai) {
            u32x4 xw[4][2]; f32x4 xa[4][2][2];
#pragma unroll
            for (int m = 0; m < 4; ++m)
#pragma unroll
                for (int bj = 0; bj < 2; ++bj) { const size_t o = (size_t)(row0 + ai * HALF + m * 16) * 2048 + col0 + bj * HALF;
                    if (SRCBF) xw[m][bj] = __builtin_nontemporal_load((const u32x4*)((const bf16_t*)xin + o));
                    else { xa[m][bj][0] = __builtin_nontemporal_load((const f32x4*)((const float*)xin + o)); xa[m][bj][1] = __builtin_nontemporal_load((const f32x4*)((const float*)xin + o + 4)); } }
            __builtin_amdgcn_sched_barrier(0);
#pragma unroll
            for (int m = 0; m < 4; ++m)
#pragma unroll
                for (int bj = 0; bj < 2; ++bj) { const size_t o = (size_t)(row0 + ai * HALF + m * 16) * 2048 + col0 + bj * HALF;
                    f32x4 v0 = acc[ai][bj][m][0], v1 = acc[ai][bj][m][1];
                    if (SRCBF) { const u32x4 q = xw[m][bj];
                        v0[0] += __uint_as_float(q.x << 16); v0[1] += __uint_as_float(q.x & 0xffff0000u); v0[2] += __uint_as_float(q.y << 16); v0[3] += __uint_as_float(q.y & 0xffff0000u);
                        v1[0] += __uint_as_float(q.z << 16); v1[1] += __uint_as_float(q.z & 0xffff0000u); v1[2] += __uint_as_float(q.w << 16); v1[3] += __uint_as_float(q.w & 0xffff0000u); }
                    else { v0 += xa[m][bj][0]; v1 += xa[m][bj][1]; }
                    u32x4 w; w.x = cvt_pk_bf16(v0[0], v0[1]); w.y = cvt_pk_bf16(v0[2], v0[3]); w.z = cvt_pk_bf16(v1[0], v1[1]); w.w = cvt_pk_bf16(v1[2], v1[3]);
                    *(u32x4*)(xout + o) = w; }
            __builtin_amdgcn_sched_barrier(0); }
    }
};
struct EpiResid {
    static constexpr bool PERM = false, AFTER_DRAIN = false;
    const float* xin; float* xout;
    __device__ __forceinline__ void operator()(const f32x4 (&acc)[2][2][4][2], const Unit& u, int wr, int wc, int fr, int fq) const {
        const int row0 = u.pm * BM + wr * 64 + fr, col0 = u.pn * BM + wc * 32 + 4 * fq;
#pragma unroll
        for (int ai = 0; ai < 2; ++ai) {
            f32x4 xv[4][2][2];
#pragma unroll
            for (int m = 0; m < 4; ++m)
#pragma unroll
                for (int bj = 0; bj < 2; ++bj)
#pragma unroll
                    for (int n = 0; n < 2; ++n) xv[m][bj][n] = *(const f32x4*)(xin + (size_t)(row0 + ai * HALF + m * 16) * 2048 + col0 + bj * HALF + n * 16);
            __builtin_amdgcn_sched_barrier(0);
#pragma unroll
            for (int m = 0; m < 4; ++m)
#pragma unroll
                for (int bj = 0; bj < 2; ++bj)
#pragma unroll
                    for (int n = 0; n < 2; ++n) *(f32x4*)(xout + (size_t)(row0 + ai * HALF + m * 16) * 2048 + col0 + bj * HALF + n * 16) = xv[m][bj][n] + acc[ai][bj][m][n];
            __builtin_amdgcn_sched_barrier(0); }
    }
};
struct EpiSwiglu {
    static constexpr bool PERM = true, AFTER_DRAIN = false;
    bf16_t* act; const float* sr;
    __device__ __forceinline__ void operator()(const f32x4 (&acc)[2][2][4][2], const Unit& u, int wr, int wc, int fr, int fq) const {
        const int row0 = u.pm * BM + wr * 64 + fr, col0 = (u.pn & 3) * 128 + wc * 32 + 8 * fq;
        float rs[2][4];
#pragma unroll
        for (int ai = 0; ai < 2; ++ai)
#pragma unroll
            for (int m = 0; m < 4; ++m) rs[ai][m] = sr[row0 + ai * HALF + m * 16];
        __builtin_amdgcn_sched_barrier(0);
#pragma unroll
        for (int ai = 0; ai < 2; ++ai)
#pragma unroll
            for (int m = 0; m < 4; ++m) { bf16_t* rowp = act + (size_t)(row0 + ai * HALF + m * 16) * 512 + col0;
                float o[8];
#pragma unroll
                for (int n = 0; n < 2; ++n)
#pragma unroll
                    for (int i = 0; i < 4; ++i) { const float g = acc[ai][0][m][n][i] * rs[ai][m], up = acc[ai][1][m][n][i] * rs[ai][m]; o[4 * n + i] = g * sigmoidf_fast(g) * up; }
                u32x4 w; w.x = cvt_pk_bf16(o[0], o[1]); w.y = cvt_pk_bf16(o[2], o[3]); w.z = cvt_pk_bf16(o[4], o[5]); w.w = cvt_pk_bf16(o[6], o[7]);
                *(u32x4*)rowp = w; }
    }
};
struct EpiDown {
    static constexpr bool PERM = true, AFTER_DRAIN = false;
    bf16_t* Y; const float* sw;
    __device__ __forceinline__ void operator()(const f32x4 (&acc)[2][2][4][2], const Unit& u, int wr, int wc, int fr, int fq) const {
        const int row0 = u.pm * BM + wr * 64 + fr, col0 = (u.pn & 7) * 256 + wc * 32 + 8 * fq;
        float swv[2][4];
#pragma unroll
        for (int ai = 0; ai < 2; ++ai)
#pragma unroll
            for (int m = 0; m < 4; ++m) swv[ai][m] = sw[row0 + ai * HALF + m * 16];
        __builtin_amdgcn_sched_barrier(0);
#pragma unroll
        for (int ai = 0; ai < 2; ++ai)
#pragma unroll
            for (int m = 0; m < 4; ++m) { const int r = row0 + ai * HALF + m * 16; const float s = swv[ai][m]; bf16_t* rowp = Y + (size_t)r * 2048 + col0;
#pragma unroll
                for (int bj = 0; bj < 2; ++bj) { const f32x4 v0 = acc[ai][bj][m][0] * s, v1 = acc[ai][bj][m][1] * s;
                    u32x4 w; w.x = cvt_pk_bf16(v0[0], v0[1]); w.y = cvt_pk_bf16(v0[2], v0[3]); w.z = cvt_pk_bf16(v1[0], v1[1]); w.w = cvt_pk_bf16(v1[2], v1[3]);
                    *(u32x4*)(rowp + bj * HALF) = w; } }
    }
};
struct MoeOrder {
    const int* tab; int ncol, G, c;
    __device__ __forceinline__ bool next(int i, Unit& u) const {
        if (G & 7) { const int nrt = __builtin_amdgcn_readfirstlane(tab[256]); const int L = i * G + c; if (L >= nrt * ncol) return false;
            const int R = L / ncol, j = L - R * ncol; u.pm = R; u.pn = __builtin_amdgcn_readfirstlane(tab[R]) * ncol + j; return true; }
        const int x = c & 7, r = c >> 3, W = G >> 3; const int* xo = tab + 320 + 9 * x;
        const int L = i * W + r; if (L >= __builtin_amdgcn_readfirstlane(xo[8]) * ncol) return false;
        const int ut = L / ncol, j = L - ut * ncol; int k = 0, base = 0;
#pragma unroll
        for (int kk = 1; kk < 8; ++kk) { const int v = __builtin_amdgcn_readfirstlane(xo[kk]); if (ut >= v) { k = kk; base = v; } }
        const int e = x + 8 * k; u.pm = __builtin_amdgcn_readfirstlane(tab[400 + e]) + (ut - base); u.pn = e * ncol + j; return true;
    }
    __device__ __forceinline__ void a_ready(const Unit&) const {}
    __device__ __forceinline__ void done(const Unit&) const {}
};
template <class Epi, class Sched, bool ALIGN_EPI = false, bool SP2 = false>
__device__ __forceinline__ void gemm_phase(PG8_LAS unsigned char* lds, const Gemm g, const Sched& S, const Epi& E) {
    int tid_ = threadIdx.x; asm volatile("" : "+v"(tid_));
    const int tid = tid_, wid = __builtin_amdgcn_readfirstlane(tid >> 6), lane = tid & 63, wr = wid >> 2, wc = wid & 3, fr = lane & 15, fq = lane >> 4;
    const int K = g.K, nt = K / BK;
    unsigned voffA[2], voffB[2];
#pragma unroll
    for (int i = 0; i < 2; ++i) { int R, C; stage_rc(tid * 16 + i * 8192, R, C); const int Rb = Epi::PERM ? ((R & ~31) + perm32(R & 31)) : R;
        voffA[i] = (unsigned)(R * K + C) * 2u; voffB[i] = (unsigned)(Rb * K + C) * 2u; }
    const size_t kstep = (size_t)(BK * 2);
    const size_t hstep = (size_t)HALF * K * 2;
    const size_t tstep = 2 * hstep;
    const unsigned ldsw = (unsigned)wid * 1024u;
    const int aoff = lds_byte(wr * 64 + fr, fq * 8), boff = lds_byte(wc * 32 + fr, fq * 8);
#define PG8_SA(b, h) (((b) * 2 + (h)) * HTB)
#define PG8_SB(b, h) ((4 + (b) * 2 + (h)) * HTB)
#define PG8_STAGE(bufoff, gbase, voff) do { _Pragma("unroll") for (int _i = 0; _i < 2; ++_i) \
        __builtin_amdgcn_global_load_lds((const unsigned*)((const char*)(gbase) + (voff)[_i]), (PG8_LAS unsigned*)(lds + (bufoff) + ldsw + _i * 8192), 16, 0, 0); } while (0)
#define PG8_LDA(dst, b, h) do { _Pragma("unroll") for (int m = 0; m < 4; ++m) _Pragma("unroll") for (int k = 0; k < 2; ++k) dst[m][k] = *(const PG8_LAS bf16x8*)(lds + PG8_SA(b, h) + aoff + m * 2048 + k * 1024); } while (0)
#define PG8_LDB(dst, b, h) do { _Pragma("unroll") for (int n = 0; n < 2; ++n) _Pragma("unroll") for (int k = 0; k < 2; ++k) dst[n][k] = *(const PG8_LAS bf16x8*)(lds + PG8_SB(b, h) + boff + n * 2048 + k * 1024); } while (0)
#define PG8_MMA(ai, bj, At, Bt) do { __builtin_amdgcn_s_setprio(1); _Pragma("unroll") for (int m = 0; m < 4; ++m) _Pragma("unroll") for (int n = 0; n < 2; ++n) _Pragma("unroll") for (int k = 0; k < 2; ++k) \
        acc[ai][bj][m][n] = __builtin_amdgcn_mfma_f32_16x16x32_bf16(Bt[n][k], At[m][k], acc[ai][bj][m][n], 0, 0, 0); __builtin_amdgcn_s_setprio(0); } while (0)
#define PG8_WAIT_V(n) asm volatile("s_waitcnt vmcnt(" #n ")" ::: "memory")
#define PG8_WAIT_L(n) asm volatile("s_waitcnt lgkmcnt(" #n ")" ::: "memory")
#define PG8_BAR __builtin_amdgcn_s_barrier()
#define PG8_SCHED __builtin_amdgcn_sched_barrier(0)
    Unit cur, nxt; int ui = 0;
    if (!S.next(0, cur)) return;
    f32x4 acc[2][2][4][2];
#pragma unroll
    for (int a = 0; a < 2; ++a)
#pragma unroll
        for (int b = 0; b < 2; ++b)
#pragma unroll
            for (int m = 0; m < 4; ++m)
#pragma unroll
                for (int n = 0; n < 2; ++n) acc[a][b][m][n] = (f32x4){0.f, 0.f, 0.f, 0.f};
    bf16x8 At[4][2], B0[2][2], B1[2][2];
    const char* cA = (const char*)g.A + (size_t)cur.pm * tstep; const char* cB = (const char*)g.Bt + (size_t)cur.pn * tstep;
    S.a_ready(cur);
    if constexpr (SP2) {
        PG8_STAGE(PG8_SB(0, 0), cB, voffB); PG8_STAGE(PG8_SB(0, 1), cB + hstep, voffB); PG8_STAGE(PG8_SA(0, 0), cA, voffA); PG8_STAGE(PG8_SA(0, 1), cA + hstep, voffA);
        if (wr == 1) PG8_BAR;
        PG8_WAIT_V(2); PG8_BAR;
        PG8_STAGE(PG8_SB(1, 0), cB + kstep, voffB); PG8_STAGE(PG8_SA(1, 0), cA + kstep, voffA); PG8_STAGE(PG8_SB(1, 1), cB + hstep + kstep, voffB);
        PG8_WAIT_V(6); PG8_BAR;
    } else {
        PG8_STAGE(PG8_SB(0, 0), cB, voffB); PG8_STAGE(PG8_SA(0, 0), cA, voffA); PG8_STAGE(PG8_SB(0, 1), cB + hstep, voffB); PG8_STAGE(PG8_SA(0, 1), cA + hstep, voffA);
        if (wr == 1) PG8_BAR;
        PG8_WAIT_V(4); PG8_BAR;
        PG8_STAGE(PG8_SB(1, 0), cB + kstep, voffB); PG8_STAGE(PG8_SA(1, 0), cA + kstep, voffA); PG8_STAGE(PG8_SB(1, 1), cB + hstep + kstep, voffB);
        PG8_WAIT_V(6); PG8_BAR;
    }
    for (;;) {
        const bool has_next = S.next(ui + 1, nxt);
        const char* nA = has_next ? (const char*)g.A + (size_t)nxt.pm * tstep : cA; const char* nB = has_next ? (const char*)g.Bt + (size_t)nxt.pn * tstep : cB;
        for (int t = 0; t < nt; t += 2) {
            const bool last = (t == nt - 2);
            const char* a1 = cA + (size_t)(t + 1) * kstep;
            const char* a2 = last ? nA : cA + (size_t)(t + 2) * kstep; const char* b2 = last ? nB : cB + (size_t)(t + 2) * kstep;
            const char* a3 = a2 + kstep; const char* b3 = b2 + kstep;
            if (last && has_next) S.a_ready(nxt);
            if constexpr (SP2) {
            PG8_LDB(B0, 0, 0); PG8_LDB(B1, 0, 1); PG8_SCHED; PG8_LDA(At, 0, 0); PG8_STAGE(PG8_SA(1, 1), a1 + hstep, voffA);
            PG8_WAIT_V(8); PG8_WAIT_L(0); PG8_BAR; PG8_MMA(0, 0, At, B0); PG8_MMA(0, 1, At, B1); PG8_BAR; PG8_SCHED;
            PG8_LDA(At, 0, 1); PG8_STAGE(PG8_SB(0, 0), b2, voffB); PG8_STAGE(PG8_SB(0, 1), b2 + hstep, voffB); PG8_STAGE(PG8_SA(0, 0), a2, voffA);
            PG8_WAIT_V(8); PG8_WAIT_L(0); PG8_BAR; PG8_MMA(1, 0, At, B0); PG8_MMA(1, 1, At, B1); PG8_BAR; PG8_SCHED;
            PG8_LDB(B0, 1, 0); PG8_LDB(B1, 1, 1); PG8_SCHED; PG8_LDA(At, 1, 0); PG8_STAGE(PG8_SA(0, 1), a2 + hstep, voffA);
            PG8_WAIT_V(8); PG8_WAIT_L(0); PG8_BAR; PG8_MMA(0, 0, At, B0); PG8_MMA(0, 1, At, B1); PG8_BAR; PG8_SCHED;
            PG8_LDA(At, 1, 1); PG8_STAGE(PG8_SB(1, 0), b3, voffB); PG8_STAGE(PG8_SB(1, 1), b3 + hstep, voffB); PG8_STAGE(PG8_SA(1, 0), a3, voffA);
            PG8_WAIT_V(8); PG8_WAIT_L(0); PG8_BAR; PG8_MMA(1, 0, At, B0); PG8_MMA(1, 1, At, B1); PG8_BAR; PG8_SCHED;
            } else {
            PG8_LDB(B0, 0, 0); PG8_SCHED; PG8_LDA(At, 0, 0); PG8_STAGE(PG8_SA(1, 1), a1 + hstep, voffA);
            PG8_WAIT_L(8); PG8_BAR; PG8_WAIT_L(0); PG8_MMA(0, 0, At, B0); PG8_BAR; PG8_SCHED;
            PG8_LDB(B1, 0, 1); PG8_STAGE(PG8_SB(0, 0), b2, voffB);
            PG8_BAR; PG8_WAIT_L(0); PG8_MMA(0, 1, At, B1); PG8_BAR;
            PG8_LDA(At, 0, 1); PG8_STAGE(PG8_SA(0, 0), a2, voffA);
            PG8_BAR; PG8_WAIT_L(0); PG8_MMA(1, 0, At, B0); PG8_BAR; PG8_SCHED;
            PG8_STAGE(PG8_SB(0, 1), b2 + hstep, voffB);
            PG8_WAIT_V(6); PG8_BAR; PG8_MMA(1, 1, At, B1); PG8_BAR;
            PG8_LDB(B0, 1, 0); PG8_SCHED; PG8_LDA(At, 1, 0); PG8_STAGE(PG8_SA(0, 1), a2 + hstep, voffA);
            PG8_WAIT_L(8); PG8_BAR; PG8_WAIT_L(0); PG8_MMA(0, 0, At, B0); PG8_BAR; PG8_SCHED;
            PG8_LDB(B1, 1, 1); PG8_STAGE(PG8_SB(1, 0), b3, voffB);
            PG8_BAR; PG8_WAIT_L(0); PG8_MMA(0, 1, At, B1); PG8_BAR;
            PG8_LDA(At, 1, 1); PG8_STAGE(PG8_SA(1, 0), a3, voffA);
            PG8_BAR; PG8_WAIT_L(0); PG8_MMA(1, 0, At, B0); PG8_BAR; PG8_SCHED;
            PG8_STAGE(PG8_SB(1, 1), b3 + hstep, voffB);
            PG8_WAIT_V(6); PG8_BAR; PG8_MMA(1, 1, At, B1); PG8_BAR;
            }
        }
        if constexpr (ALIGN_EPI) { if (wr == 0) PG8_BAR; }
        if constexpr (!Epi::AFTER_DRAIN) { E(acc, cur, wr, wc, fr, fq); S.done(cur); }
        if (!has_next) break;
#pragma unroll
        for (int a = 0; a < 2; ++a)
#pragma unroll
            for (int b = 0; b < 2; ++b)
#pragma unroll
                for (int m = 0; m < 4; ++m)
#pragma unroll
                    for (int n = 0; n < 2; ++n) acc[a][b][m][n] = (f32x4){0.f, 0.f, 0.f, 0.f};
        cur = nxt; cA = nA; cB = nB; ++ui;
        if constexpr (ALIGN_EPI) { if (wr == 1) PG8_BAR; }
    }
    PG8_WAIT_V(0);
    if constexpr (!ALIGN_EPI) { if (wr == 0) PG8_BAR; }
    PG8_BAR;
    if constexpr (Epi::AFTER_DRAIN) { E.fused(acc, cur, wr, wc, fr, fq, lds, wid, lane); S.done(cur); }
#undef PG8_SA
#undef PG8_SB
#undef PG8_STAGE
#undef PG8_LDA
#undef PG8_LDB
#undef PG8_MMA
#undef PG8_WAIT_V
#undef PG8_WAIT_L
#undef PG8_BAR
#undef PG8_SCHED
}
}
constexpr int NWAVES = 8;
constexpr int NTOK = 16384, DM = 2048, SEQ = 4096, NBATCH = 4, NH = 16, DEPTH = 2;
constexpr int DIN = 13392, NBIG = 13312;
constexpr int NEXP = 64, DEXP = 512, NASG = 2 * NTOK, MAXSLOT = 49152;
constexpr float EPS = 1e-6f, LOG2E = 1.4426950408889634f;

constexpr size_t MiB = 1u << 20;
constexpr size_t WS_CTL = 0, CTL_ZERO_BYTES = 1 * MiB;
constexpr size_t WS_TAB = 1 * MiB;
constexpr size_t WS_GN = 1 * MiB + 4096;
constexpr size_t WS_PART = 1 * MiB + 65536;
constexpr size_t WS_RS = 1 * MiB + 655360, WS_RS2 = 1 * MiB + 720896;
constexpr size_t WS_WIN = 2 * MiB, WS_WSK = 54 * MiB, WS_WUQ = 55 * MiB, WS_WUKV = 58 * MiB, WS_WBA = 62 * MiB, WS_WBB = 70 * MiB, WS_WBC = 74 * MiB,
                 WS_WOUT = 78 * MiB, WS_WRT = 86 * MiB, WS_WGU = 88 * MiB, WS_WD = 344 * MiB;
constexpr size_t WS_XN = 472 * MiB;
constexpr size_t WS_CQ = 536 * MiB, WS_CKV = 552 * MiB;
constexpr size_t WS_QKV6 = 568 * MiB;
constexpr size_t WS_GATES = 760 * MiB;
constexpr size_t WS_SK = 952 * MiB;
constexpr size_t WS_ROPE = 958 * MiB;
constexpr size_t WS_CUMF = 962 * MiB;
constexpr size_t WS_QM = 964 * MiB, WS_KM = 1060 * MiB;
constexpr size_t WS_VM = 1156 * MiB, WS_KNOPE = 1220 * MiB;
constexpr size_t WS_OA = 1284 * MiB, WS_OB = 1348 * MiB, WS_OC = 1380 * MiB;
constexpr size_t WS_MF = 1412 * MiB, WS_MB = 1540 * MiB;
constexpr size_t WS_HS = WS_QKV6;
constexpr size_t WS_ACT = WS_GATES;
constexpr size_t WS_Y = WS_QM;
constexpr size_t WS_ASG = 1604 * MiB;
constexpr size_t WS_XB = 1606 * MiB;
constexpr size_t WS_END = 1734 * MiB;
constexpr int CW_BAR = 4096;
constexpr int CW_AQ = 12288;
constexpr int CW_CNT = 8192;

constexpr int RING_OFF = 0, RING_BYTES = 139264;
constexpr int LDSCTL_OFF = RING_BYTES, MISC_OFF = LDSCTL_OFF + 320;
constexpr int LDS_BYTES = 147456;

#define GAS __attribute__((address_space(1)))
#define LAS __attribute__((address_space(3)))
typedef unsigned short bf16;
typedef unsigned v4u __attribute__((ext_vector_type(4)));
typedef unsigned v2u __attribute__((ext_vector_type(2)));
typedef float f32x4 __attribute__((ext_vector_type(4)));
typedef float f32x16 __attribute__((ext_vector_type(16)));
typedef short bf16x8 __attribute__((ext_vector_type(8)));
typedef short s16x4 __attribute__((ext_vector_type(4)));
typedef GAS unsigned gu32;
#define LDS_WAIT() asm volatile("s_waitcnt lgkmcnt(0)" ::: "memory")
#define VM_WAIT() asm volatile("s_waitcnt vmcnt(0)" ::: "memory")
__device__ __forceinline__ unsigned f2bf(float f) { unsigned u = __builtin_bit_cast(unsigned, f); return (u + 0x7fffu + ((u >> 16) & 1u)) >> 16; }
__device__ __forceinline__ unsigned pk2(float lo, float hi) { unsigned r; asm("v_cvt_pk_bf16_f32 %0, %1, %2" : "=v"(r) : "v"(lo), "v"(hi)); return r; }
__device__ __forceinline__ void glds16(const void* gsrc, unsigned lds_dst) { unsigned keep;
    asm volatile("s_mov_b32 %0, m0\n\ts_mov_b32 m0, %2\n\ts_nop 0\n\tglobal_load_lds_dwordx4 %1, off\n\ts_mov_b32 m0, %0" : "=&s"(keep) : "v"(gsrc), "s"(lds_dst) : "memory"); }
__device__ __forceinline__ void glds4(const void* gsrc, unsigned lds_dst) { unsigned keep;
    asm volatile("s_mov_b32 %0, m0\n\ts_mov_b32 m0, %2\n\ts_nop 0\n\tglobal_load_lds_dword %1, off\n\ts_mov_b32 m0, %0" : "=&s"(keep) : "v"(gsrc), "s"(lds_dst) : "memory"); }
__device__ __forceinline__ float bflo(unsigned w) { return __uint_as_float(w << 16); }
__device__ __forceinline__ float bfhi(unsigned w) { return __uint_as_float(w & 0xffff0000u); }
using pg8::bperm_xor;
__device__ __forceinline__ float bperm_up(float v, int d, int lane) { return __int_as_float(__builtin_amdgcn_ds_bpermute((lane - d) << 2, __float_as_int(v))); }
__device__ __forceinline__ float wave_sum(float v, int lane) {
#pragma unroll
    for (int o = 1; o < 64; o <<= 1) v += bperm_xor(v, o, lane);
    return v;
}
static_assert(pg8::EpiSeg::O_CQ == WS_CQ && pg8::EpiSeg::O_CKV == WS_CKV && pg8::EpiSeg::O_QKV6 == WS_QKV6 && pg8::EpiSeg::O_GATES == WS_GATES && pg8::EpiSeg::O_PART == WS_PART && pg8::EpiSeg::O_RS == WS_RS, "EpiSeg offsets vs workspace map");
#define XB_TMO      128
#define XB_XCNT(j)  (256  + 64 * (j))
#define XB_XSUB(j)  (1280 + 64 * (j))
#define XB_XGEN(j)  (2304 + 64 * (j))
#define XB_TOP      3328
#define XB_TOPGEN   3392
#define XCD_BAR_WORDS 3456
#define XB_SPIN_CAP (1u << 18)

__device__ __forceinline__ unsigned xb_ld(unsigned* p)              { return __hip_atomic_load(p, __ATOMIC_RELAXED, __HIP_MEMORY_SCOPE_AGENT); }
__device__ __forceinline__ unsigned xb_add(unsigned* p, unsigned v) { return __hip_atomic_fetch_add(p, v, __ATOMIC_RELAXED, __HIP_MEMORY_SCOPE_AGENT); }
__device__ __forceinline__ unsigned xb_xcc_id() { return (unsigned)__builtin_amdgcn_s_getreg((3 << 11) | 20) & 0xFu; }
#define XB_SPIN(cond, bar) do { unsigned _sp = 0; while (cond) { __builtin_amdgcn_s_sleep(1); \
    if ((++_sp & 255u) == 0u) { if (xb_ld(&(bar)[XB_TMO])) break; if (_sp > XB_SPIN_CAP) { atomicAdd(&(bar)[XB_TMO], 1u); break; } } } } while (0)

struct XcdBarrier {
    unsigned* bar; unsigned x;
    volatile LAS unsigned* st;
};

__device__ __forceinline__ XcdBarrier xcd_barrier_post(unsigned* bar, volatile LAS unsigned* st) {
    XcdBarrier b; b.bar = bar; b.x = xb_xcc_id(); b.st = st;
    if (threadIdx.x == 0) (void)xb_add(&bar[XB_XCNT(b.x)], 1u);
    return b;
}
__device__ __forceinline__ void xcd_barrier_complete(unsigned* bar, unsigned x, unsigned& nloc, unsigned& nx) {
    const unsigned G = gridDim.x * gridDim.y * gridDim.z;
    unsigned sum, cnt, mine, sp = 0u;
    for (;;) {
        sum = 0u; cnt = 0u; mine = 0u;
#pragma unroll
        for (unsigned j = 0; j < 16; ++j) { const unsigned c = xb_ld(&bar[XB_XCNT(j)]); sum += c; cnt += (c > 0u) ? 1u : 0u; mine = (j == x) ? c : mine; }
        if (sum == G) break;
        __builtin_amdgcn_s_sleep(1);
        if ((++sp & 255u) == 0u) { if (xb_ld(&bar[XB_TMO])) break; if (sp > XB_SPIN_CAP) { atomicAdd(&bar[XB_TMO], 1u); break; } }
    }
    nloc = mine > 0u ? mine : 1u; nx = cnt > 0u ? cnt : 1u;
}

__device__ __forceinline__ void xcd_barrier(const XcdBarrier& b) {
    asm volatile("s_waitcnt vmcnt(0)" ::: "memory");
    __syncthreads();
    if (threadIdx.x == 0) {
        unsigned* bar = b.bar;
        __builtin_amdgcn_s_waitcnt(0);
        unsigned nloc = b.st[0], nx = b.st[1];
        if (nloc == 0u) { xcd_barrier_complete(bar, b.x, nloc, nx); b.st[0] = nloc; b.st[1] = nx; }
        const unsigned old = xb_add(&bar[XB_XSUB(b.x)], 1u);
        const unsigned gen = old / nloc;
        if (old + 1u == (gen + 1u) * nloc) {
            __builtin_amdgcn_fence(__ATOMIC_RELEASE, "agent");
            asm volatile("s_waitcnt vmcnt(0)" ::: "memory");
            const unsigned og = xb_add(&bar[XB_TOP], 1u);
            const unsigned tg = og / nx;
            if (og + 1u == (tg + 1u) * nx) xb_add(&bar[XB_TOPGEN], 1u);
            else XB_SPIN(xb_ld(&bar[XB_TOPGEN]) == tg, bar);
            __builtin_amdgcn_fence(__ATOMIC_ACQUIRE, "agent");
            xb_add(&bar[XB_XGEN(b.x)], 1u);
            asm volatile("s_waitcnt vmcnt(0)" ::: "memory");
        } else {
            XB_SPIN(xb_ld(&bar[XB_XGEN(b.x)]) == gen, bar);
            __builtin_amdgcn_fence(__ATOMIC_ACQUIRE, "agent");
            asm volatile("s_waitcnt vmcnt(0)" ::: "memory");
        }
    }
    __syncthreads();
}

template <int PMODE = 0> __device__ __forceinline__ void conv_item64(const float* __restrict__ src, int ld, int K, int scol0, bf16* dst, int drow0, int nvalid, int kb, int lane, LAS unsigned char* tile, const float* kgain = nullptr, bool split = false) {
    const int g = lane >> 4, c = lane & 15, k0 = 64 * kb + 16 * g; const bool ok = 4 * c < nvalid;
    f32x4 v[16]; const float* p = src + (size_t)k0 * ld + scol0 + 4 * c;
#pragma unroll
    for (int i = 0; i < 16; ++i) v[i] = (ok && PMODE != 2) ? __builtin_nontemporal_load((const GAS f32x4*)(p + (size_t)i * ld)) : (f32x4){0.f, 0.f, 0.f, 0.f};
    if (kgain) {
#pragma unroll
        for (int i4 = 0; i4 < 4; ++i4) { const f32x4 kg = *(const GAS f32x4*)(kgain + k0 + 4 * i4); v[4 * i4] *= kg[0]; v[4 * i4 + 1] *= kg[1]; v[4 * i4 + 2] *= kg[2]; v[4 * i4 + 3] *= kg[3]; } }
#pragma unroll
    for (int j = 0; j < 4; ++j) { v4u o0, o1;
        o0.x = pk2(v[0][j], v[1][j]); o0.y = pk2(v[2][j], v[3][j]); o0.z = pk2(v[4][j], v[5][j]); o0.w = pk2(v[6][j], v[7][j]);
        o1.x = pk2(v[8][j], v[9][j]); o1.y = pk2(v[10][j], v[11][j]); o1.z = pk2(v[12][j], v[13][j]); o1.w = pk2(v[14][j], v[15][j]);
        LAS unsigned char* tp = tile + (4 * c + j) * 144 + 32 * g; *(LAS v4u*)tp = o0; *(LAS v4u*)(tp + 16) = o1; }
    LDS_WAIT(); asm volatile("" ::: "memory");
#pragma unroll
    for (int s = 0; s < 8; ++s) { const int row = (lane >> 3) + 8 * s, ch = lane & 7; const v4u w = *(const LAS v4u*)(tile + row * 144 + 16 * ch);
        const int drow = drow0 + row + ((split && row >= 32) ? 96 : 0);
        if (row < nvalid) { bf16* dp = dst + (size_t)drow * K + 64 * kb + 8 * ch;
            if (PMODE == 3) asm volatile("global_store_dwordx4 %0, %1, off sc0 sc1" :: "v"(dp), "v"(w) : "memory");
            else *(GAS v4u*)dp = w; } }
    LDS_WAIT(); asm volatile("" ::: "memory");
}
struct ConvSrc { const float *w_in, *w_uq, *w_ukv, *w_ba, *w_bb, *w_bc, *w_out, *g_cq, *g_ckv, *w_eg, *w_eu, *w_ed; };
template <int PMODE = 0> __device__ __forceinline__ void phase_convert(const ConvSrc& S, unsigned char* ws, int it_begin, int it_stride, int it_end, int lane, LAS unsigned char* tile) {
    bf16* WIN = (bf16*)(ws + WS_WIN); bf16* WUQ = (bf16*)(ws + WS_WUQ); bf16* WUKV = (bf16*)(ws + WS_WUKV);
    bf16* WBA = (bf16*)(ws + WS_WBA); bf16* WBB = (bf16*)(ws + WS_WBB); bf16* WBC = (bf16*)(ws + WS_WBC); bf16* WOUT = (bf16*)(ws + WS_WOUT);
    bf16* WGU = (bf16*)(ws + WS_WGU); bf16* WD = (bf16*)(ws + WS_WD);
    constexpr int I_IN0 = 16 * 32, I_IN1 = 96 * 32, I_IN2 = 96 * 32, I_SK0 = 1 * 32, I_SK1 = 1 * 32, I_UQ = 48 * 8, I_UKV = 64 * 8,
                  I_BA = 32 * 32, I_BB = 32 * 16, I_BC = 32 * 16, I_OUT = 32 * 32, I_GU = 16 * 32, I_D = 32 * 8, I_EXP = I_GU + I_D;
    constexpr int I_DENSE = I_IN0 + I_IN1 + I_IN2 + I_UQ + I_UKV + I_BA + I_BB + I_BC + I_OUT;
    constexpr int NITEMS = I_DENSE + NEXP * I_EXP;
    for (int it = it_begin; it < it_end; it += it_stride) {
        int r = it; const float* src; int ld, K, scol0, drow0, nvalid = 64, kb, nblk = 1; bf16* dst; const float* kg = nullptr; bool split = false; int jobid = 0;
        if (r >= I_DENSE) { r -= I_DENSE; const int e = r / I_EXP; r -= e * I_EXP;
            if (r < I_GU) { const int b = r & 15; kb = r >> 4; const int j = b >> 2, t = b & 3; ld = 512; K = 2048; dst = WGU + (size_t)e * 1024 * 2048; drow0 = 64 * b;
                if (t < 2) { src = S.w_eg + (size_t)e * 2048 * 512; scol0 = 128 * j + 64 * t; } else { src = S.w_eu + (size_t)e * 2048 * 512; scol0 = 128 * j + 64 * (t - 2); } }
            else { r -= I_GU; const int b = r & 31; kb = r >> 5; ld = 2048; K = 512; src = S.w_ed + (size_t)e * 512 * 2048; scol0 = 64 * b; dst = WD + (size_t)e * 2048 * 512; drow0 = 64 * b; }
        } else {
            if (r < I_IN0) { src = S.w_in; ld = DIN; K = 2048; nblk = 16; scol0 = 0; dst = WIN; drow0 = 0; }
            else if ((r -= I_IN0) < I_IN1) { src = S.w_in; ld = DIN; K = 2048; nblk = 96; scol0 = 1088; dst = WIN; drow0 = 1024; jobid = 1; }
            else if ((r -= I_IN1) < I_IN2) { src = S.w_in; ld = DIN; K = 2048; nblk = 96; scol0 = 7248; dst = WIN; drow0 = 7168; }
            else if ((r -= I_IN2) < I_UQ) { src = S.w_uq; ld = 3072; K = 512; nblk = 48; scol0 = 0; dst = WUQ; drow0 = 0; kg = S.g_cq; }
            else if ((r -= I_UQ) < I_UKV) { src = S.w_ukv; ld = 4096; K = 512; nblk = 64; scol0 = 0; dst = WUKV; drow0 = 0; kg = S.g_ckv; }
            else if ((r -= I_UKV) < I_BA) { src = S.w_ba; ld = 2048; K = 2048; nblk = 32; scol0 = 0; dst = WBA; drow0 = 0; }
            else if ((r -= I_BA) < I_BB) { src = S.w_bb; ld = 2048; K = 1024; nblk = 32; scol0 = 0; dst = WBB; drow0 = 0; }
            else if ((r -= I_BB) < I_BC) { src = S.w_bc; ld = 2048; K = 1024; nblk = 32; scol0 = 0; dst = WBC; drow0 = 0; }
            else { r -= I_BC; src = S.w_out; ld = 2048; K = 2048; nblk = 32; scol0 = 0; dst = WOUT; drow0 = 0; }
            const int b = r % nblk; kb = r / nblk; scol0 += 64 * b; drow0 += 64 * b;
            if (jobid == 1) { const int seg = b >> 4;
                if (seg != 2 && seg != 5) { split = true; drow0 = 1024 + 256 * (b >> 2) + 32 * (b & 3); } }
        }
        conv_item64<PMODE>(src, ld, K, scol0, dst, drow0, nvalid, kb, lane, tile, kg, split);
    }
}
constexpr int CONV_EXP_ITEMS = NEXP * (16 * 32 + 32 * 8);
struct ConvItem { const float* src; bf16* dst; int ld, K, scol0, drow0, kb; };
__device__ __forceinline__ ConvItem conv_expert_decode(const float* w_eg, const float* w_eu, const float* w_ed, bf16* WGU, bf16* WD, int it) {
    ConvItem I; const int e = it / 768; int r = it - e * 768;
    if (r < 512) { const int b = r & 15; I.kb = r >> 4; const int j = b >> 2, t = b & 3; I.ld = 512; I.K = 2048; I.dst = WGU + (size_t)e * 1024 * 2048; I.drow0 = 64 * b;
        if (t < 2) { I.src = w_eg + (size_t)e * 2048 * 512; I.scol0 = 128 * j + 64 * t; } else { I.src = w_eu + (size_t)e * 2048 * 512; I.scol0 = 128 * j + 64 * (t - 2); } }
    else { r -= 512; const int b = r & 31; I.kb = r >> 5; I.ld = 2048; I.K = 512; I.src = w_ed + (size_t)e * 512 * 2048; I.scol0 = 64 * b; I.dst = WD + (size_t)e * 2048 * 512; I.drow0 = 64 * b; }
    return I;
}
__device__ __forceinline__ void conv_load64(const ConvItem& I, int lane, f32x4 (&v)[16]) {
    const int g = lane >> 4, c = lane & 15, k0 = 64 * I.kb + 16 * g; const float* p = I.src + (size_t)k0 * I.ld + I.scol0 + 4 * c;
#pragma unroll
    for (int i = 0; i < 16; ++i) v[i] = __builtin_nontemporal_load((const GAS f32x4*)(p + (size_t)i * I.ld));
}
__device__ __forceinline__ void conv_store64(const ConvItem& I, int lane, LAS unsigned char* tile, const f32x4 (&v)[16]) {
    const int g = lane >> 4, c = lane & 15;
#pragma unroll
    for (int j = 0; j < 4; ++j) { v4u o0, o1;
        o0.x = pk2(v[0][j], v[1][j]); o0.y = pk2(v[2][j], v[3][j]); o0.z = pk2(v[4][j], v[5][j]); o0.w = pk2(v[6][j], v[7][j]);
        o1.x = pk2(v[8][j], v[9][j]); o1.y = pk2(v[10][j], v[11][j]); o1.z = pk2(v[12][j], v[13][j]); o1.w = pk2(v[14][j], v[15][j]);
        LAS unsigned char* tp = tile + (4 * c + j) * 144 + 32 * g; *(LAS v4u*)tp = o0; *(LAS v4u*)(tp + 16) = o1; }
    LDS_WAIT(); asm volatile("" ::: "memory");
#pragma unroll
    for (int s = 0; s < 8; ++s) { const int row = (lane >> 3) + 8 * s, ch = lane & 7; const v4u w = *(const LAS v4u*)(tile + row * 144 + 16 * ch);
        __builtin_nontemporal_store(w, (GAS v4u*)(I.dst + (size_t)(I.drow0 + row) * I.K + 64 * I.kb + 8 * ch)); }
    LDS_WAIT(); asm volatile("" ::: "memory");
}
__device__ __forceinline__ ConvItem conv_late_dense_decode(const float* w_ba, const float* w_bb, const float* w_bc, const float* w_out, unsigned char* ws, int d) {
    ConvItem I; I.ld = 2048; int r = d;
    if (r < 1024) { I.src = w_ba; I.dst = (bf16*)(ws + WS_WBA); I.K = 2048; }
    else if ((r -= 1024) < 512) { I.src = w_bb; I.dst = (bf16*)(ws + WS_WBB); I.K = 1024; }
    else if ((r -= 512) < 512) { I.src = w_bc; I.dst = (bf16*)(ws + WS_WBC); I.K = 1024; }
    else { r -= 512; I.src = w_out; I.dst = (bf16*)(ws + WS_WOUT); I.K = 2048; }
    const int b = r & 31; I.kb = r >> 5; I.scol0 = 64 * b; I.drow0 = 64 * b; return I;
}
__device__ __forceinline__ void conv_expert_items(const float* w_eg, const float* w_eu, const float* w_ed, const float* w_ba, const float* w_bb, const float* w_bc, const float* w_out, unsigned char* ws, int first, int dense_item, LAS unsigned char* tile) {
    int t_ = threadIdx.x; asm volatile("" : "+v"(t_)); const int lane = t_ & 63;
    bf16* WGU = (bf16*)(ws + WS_WGU); bf16* WD = (bf16*)(ws + WS_WD);
    f32x4 va[16], vb[16];
    ConvItem Ia = conv_expert_decode(w_eg, w_eu, w_ed, WGU, WD, first), Ib;
    conv_load64(Ia, lane, va);
#pragma unroll 1
    for (int j = 0; j < 16; j += 2) {
        Ib = conv_expert_decode(w_eg, w_eu, w_ed, WGU, WD, first + (j + 1) * 8);
        conv_load64(Ib, lane, vb); __builtin_amdgcn_sched_barrier(0);
        conv_store64(Ia, lane, tile, va); __builtin_amdgcn_sched_barrier(0);
        Ia = (j + 2 < 16) ? conv_expert_decode(w_eg, w_eu, w_ed, WGU, WD, first + (j + 2) * 8) : conv_late_dense_decode(w_ba, w_bb, w_bc, w_out, ws, dense_item);
        conv_load64(Ia, lane, va); __builtin_amdgcn_sched_barrier(0);
        conv_store64(Ib, lane, tile, vb); __builtin_amdgcn_sched_barrier(0);
    }
    conv_store64(Ia, lane, tile, va);
}
__device__ __forceinline__ void phase_convert_small(const float* w_in_l, const float* w_group_l, const float* w_router_l, bf16* WSK, bf16* WRT, int tid_g, int nthr_g) {
    for (int i = tid_g; i < 2 * 80 * 256; i += nthr_g) { const int which = i / (80 * 256), r = i - which * (80 * 256), n = r >> 8, k8 = r & 255; float v[8];
        if (which == 0) { const float* s = w_in_l + (size_t)(8 * k8) * DIN + (n < 64 ? 1024 + n : 7232 + (n - 64));
#pragma unroll
            for (int j = 0; j < 8; ++j) v[j] = s[(size_t)j * DIN]; }
        else {
#pragma unroll
            for (int j = 0; j < 8; ++j) { const int k = 8 * k8 + j; v[j] = n < 8 ? w_group_l[k * 8 + n] : (n < 72 ? w_router_l[k * 64 + (n - 8)] : 0.f); } }
        v4u o; o.x = pk2(v[0], v[1]); o.y = pk2(v[2], v[3]); o.z = pk2(v[4], v[5]); o.w = pk2(v[6], v[7]);
        const size_t idx = ((size_t)(((k8 >> 2) * 5 + (n >> 4)) * 64 + (k8 & 3) * 16 + (n & 15))) * 8;
        *(GAS v4u*)((which == 0 ? WSK : WRT) + idx) = o; }
}

__device__ __forceinline__ void phase_rmsnorm(const float* x, const float* gain, bf16* out, int gw, int NGW, int lane) {
    f32x4 g[8];
#pragma unroll
    for (int j = 0; j < 8; ++j) g[j] = ((const GAS f32x4*)gain)[lane + 64 * j];
    for (int row = gw; row < NTOK; row += NGW) {
        const GAS f32x4* xr = (const GAS f32x4*)(x + (size_t)row * DM) + lane; f32x4 v[8]; float s = 0.f;
#pragma unroll
        for (int j = 0; j < 8; ++j) { v[j] = xr[64 * j]; s += (v[j].x * v[j].x + v[j].y * v[j].y) + (v[j].z * v[j].z + v[j].w * v[j].w); }
        const float r = 1.0f / sqrtf(wave_sum(s, lane) * (1.0f / DM) + EPS);
        GAS v2u* o = (GAS v2u*)(out + (size_t)row * DM) + lane;
#pragma unroll
        for (int j = 0; j < 8; ++j) { v2u w; w.x = pk2(v[j].x * r * g[j].x, v[j].y * r * g[j].y); w.y = pk2(v[j].z * r * g[j].z, v[j].w * r * g[j].w); o[64 * j] = w; }
    }
}

__device__ __forceinline__ void skinny16x80(const bf16* A, const bf16* Wt, int row0, int lane, f32x4 (&acc)[5]) {
#pragma unroll
    for (int t = 0; t < 5; ++t) acc[t] = (f32x4){0.f, 0.f, 0.f, 0.f};
    const bf16* ap = A + (size_t)(row0 + (lane & 15)) * 2048 + 8 * (lane >> 4);
    const bf16* bp = Wt + (size_t)(lane & 15) * 2048 + 8 * (lane >> 4);
#pragma unroll 4
    for (int k0 = 0; k0 < 2048; k0 += 32) {
        const bf16x8 a = *(const GAS bf16x8*)(ap + k0);
#pragma unroll
        for (int t = 0; t < 5; ++t) { const bf16x8 b = *(const GAS bf16x8*)(bp + (size_t)t * 16 * 2048 + k0); acc[t] = __builtin_amdgcn_mfma_f32_16x16x32_bf16(a, b, acc[t], 0, 0, 0); }
    }
}
__device__ __forceinline__ void phase_skinny_store(const bf16* A, const bf16* Wt, float* out, int gw, int NGW, int lane) {
    for (int rg = gw; rg < NTOK / 16; rg += NGW) { f32x4 acc[5]; skinny16x80(A, Wt, rg * 16, lane, acc);
#pragma unroll
        for (int t = 0; t < 5; ++t)
#pragma unroll
            for (int i = 0; i < 4; ++i) out[(size_t)(rg * 16 + 4 * (lane >> 4) + i) * 80 + 16 * t + (lane & 15)] = acc[t][i]; }
}

template <bool COMBINE, bool ROUTE, bool XBF = false>
__device__ __forceinline__ void phase_norm_skinny(const void* __restrict__ xsrc_, void* __restrict__ xdst_, const bf16* __restrict__ Y, const int* __restrict__ tslot, const float* __restrict__ gain, const bf16* __restrict__ Wf, bf16* __restrict__ XNo, float* __restrict__ RSo, float* __restrict__ out80,
                                                  unsigned* cnt, int* __restrict__ asg_e, int* __restrict__ asg_pos, float* __restrict__ asg_w, LAS unsigned char* lds, int gw, int NGW, int wave, int lane, const float* __restrict__ gkr = nullptr, const float* __restrict__ ropet = nullptr, float* __restrict__ ssro = nullptr) {
    constexpr int AST = 528;
    LAS unsigned char* at = lds + wave * (8 * AST);
    LAS float* lg = (LAS float*)(lds + 8 * 8 * AST + wave * 2560);
    const int kq = lane >> 4;
    for (int g8 = gw; g8 < NTOK / 8; g8 += NGW) {
        const int row0 = g8 * 8;
        const float* __restrict__ xb = (const float*)xsrc_ + (size_t)row0 * DM + 4 * lane; const bf16* __restrict__ xbh = (const bf16*)xsrc_ + (size_t)row0 * DM + 4 * lane;
        int s0[8], s1[8];
        if (COMBINE) {
#pragma unroll
            for (int r = 0; r < 8; ++r) { s0[r] = __builtin_amdgcn_readfirstlane(tslot[2 * (row0 + r)]); s1[r] = __builtin_amdgcn_readfirstlane(tslot[2 * (row0 + r) + 1]); } }
        float ssr[8];
#pragma unroll
        for (int r = 0; r < 8; ++r) ssr[r] = 0.f;
        f32x4 acc[5];
#pragma unroll
        for (int t = 0; t < 5; ++t) acc[t] = (f32x4){0.f, 0.f, 0.f, 0.f};
        f32x4 xv[8]; v2u ya[8], yb[8], xh[8]; bf16x8 wf[2][2][5]; f32x4 g4;
        const bf16* __restrict__ yl = Y + 4 * lane; const float* __restrict__ gl = gain + 4 * lane; bf16* __restrict__ xnl = XNo + (size_t)row0 * DM + 4 * lane; float* __restrict__ xdl = (COMBINE && !XBF) ? (float*)xdst_ + (size_t)row0 * DM + 4 * lane : nullptr; bf16* __restrict__ xdh = (COMBINE && XBF) ? (bf16*)xdst_ + (size_t)row0 * DM + 4 * lane : nullptr;
#define FNS_LOADX(c_) do { int co_ = 256 * (c_); asm volatile("" : "+s"(co_));        \
            _Pragma("unroll") for (int r = 0; r < 8; ++r) { if (XBF) xh[r] = __builtin_nontemporal_load((const GAS v2u*)(xbh + (r * DM + co_))); else xv[r] = __builtin_nontemporal_load((const GAS f32x4*)(xb + (r * DM + co_))); \
            if (COMBINE) { ya[r] = __builtin_nontemporal_load((const GAS v2u*)(yl + ((size_t)s0[r] * DM + co_))); yb[r] = __builtin_nontemporal_load((const GAS v2u*)(yl + ((size_t)s1[r] * DM + co_))); } } \
            g4 = *(const GAS f32x4*)(gl + co_); } while (0)
#define FNS_LOADW(buf, gb_) do { const bf16* __restrict__ wp_ = Wf + ((size_t)(2 * (gb_)) * 5 * 64 + lane) * 8; \
            _Pragma("unroll") for (int s = 0; s < 2; ++s) _Pragma("unroll") for (int t = 0; t < 5; ++t) wf[buf][s][t] = *(const GAS bf16x8*)(wp_ + (size_t)(s * 5 + t) * 512); } while (0)
        if (!COMBINE) FNS_LOADX(0);
        FNS_LOADW(0, 0);
#pragma unroll 1
        for (int c = 0; c < 8; ++c) {
            if (COMBINE) FNS_LOADX(c);
            __builtin_amdgcn_sched_barrier(0);
            int cs_ = 256 * c; asm volatile("" : "+s"(cs_));
#pragma unroll
            for (int r = 0; r < 8; ++r) { f32x4 a; if (XBF) a = (f32x4){bflo(xh[r].x), bfhi(xh[r].x), bflo(xh[r].y), bfhi(xh[r].y)}; else a = xv[r];
                if (COMBINE) { a.x += bflo(ya[r].x) + bflo(yb[r].x); a.y += bfhi(ya[r].x) + bfhi(yb[r].x); a.z += bflo(ya[r].y) + bflo(yb[r].y); a.w += bfhi(ya[r].y) + bfhi(yb[r].y);
                    if (XBF) { v2u xo; xo.x = pk2(a.x, a.y); xo.y = pk2(a.z, a.w); *(GAS v2u*)(xdh + (r * DM + cs_)) = xo; } else *(GAS f32x4*)(xdl + (r * DM + cs_)) = a; }
                ssr[r] += (a.x * a.x + a.y * a.y) + (a.z * a.z + a.w * a.w);
                v2u p; p.x = pk2(a.x * g4.x, a.y * g4.y); p.y = pk2(a.z * g4.z, a.w * g4.w);
                *(GAS v2u*)(xnl + (r * DM + cs_)) = p;
                *(LAS v2u*)(at + r * AST + 8 * lane) = p; }
            LDS_WAIT(); __builtin_amdgcn_sched_barrier(0);
            if (!COMBINE && c + 1 < 8) FNS_LOADX(c + 1);
            const LAS unsigned char* ap = at + (lane & 7) * AST + 16 * kq;
#pragma unroll
            for (int q = 0; q < 4; ++q) {
                if (4 * c + q + 1 < 32) FNS_LOADW((q + 1) & 1, 4 * c + q + 1);
                __builtin_amdgcn_sched_barrier(0);
#pragma unroll
                for (int s = 0; s < 2; ++s) { const bf16x8 af = *(const LAS bf16x8*)(ap + 64 * (2 * q + s));
#pragma unroll
                    for (int t = 0; t < 5; ++t) acc[t] = __builtin_amdgcn_mfma_f32_16x16x32_bf16(af, wf[q & 1][s][t], acc[t], 0, 0, 0); }
                __builtin_amdgcn_sched_barrier(0); }
            LDS_WAIT(); __builtin_amdgcn_sched_barrier(0); }
#undef FNS_LOADX
#undef FNS_LOADW
        float rr[8];
#pragma unroll
        for (int r = 0; r < 8; ++r) rr[r] = 1.0f / sqrtf(wave_sum(ssr[r], lane) * (1.0f / DM) + EPS);
        if (lane < 8) { float rv = rr[0];
#pragma unroll
            for (int r = 1; r < 8; ++r) rv = (lane == r) ? rr[r] : rv;
            RSo[row0 + lane] = rv; }
#pragma unroll
        for (int i = 0; i < 4; ++i) { const float ri = (lane < 16) ? rr[i] : rr[4 + i];
#pragma unroll
            for (int t = 0; t < 5; ++t) acc[t][i] *= ri; }
        if (!ROUTE) {
            const int jl = lane & 15, rbase = row0 + 4 * (lane >> 4);
#pragma unroll
            for (int i = 0; i < 4; ++i) { float sq = (acc[0][i] * acc[0][i] + acc[1][i] * acc[1][i]) + (acc[2][i] * acc[2][i] + acc[3][i] * acc[3][i]);
                sq += bperm_xor(sq, 1, lane); sq += bperm_xor(sq, 2, lane); sq += bperm_xor(sq, 4, lane); sq += bperm_xor(sq, 8, lane);
                if (lane < 32 && jl == 0) ssro[rbase + i] = sq; }
            if (lane < 32) {
#pragma unroll
                for (int t = 0; t < 2; ++t) { const int jj = 16 * t + jl; const float g1 = gkr[jj], g2 = gkr[32 + jj];
#pragma unroll
                    for (int i = 0; i < 4; ++i) { const size_t rw = (size_t)(rbase + i); const float cc = ropet[rw * 32 + jj], sv = ropet[(size_t)NTOK * 32 + rw * 32 + jj];
                        const float x1 = acc[t][i] * g1, x2 = acc[t + 2][i] * g2;
                        out80[rw * 80 + jj] = x1 * cc - x2 * sv; out80[rw * 80 + 32 + jj] = x2 * cc + x1 * sv; } }
#pragma unroll
                for (int i = 0; i < 4; ++i) out80[(size_t)(rbase + i) * 80 + 64 + jl] = acc[4][i]; } }
        else {
            if (lane < 32) {
#pragma unroll
                for (int t = 0; t < 5; ++t)
#pragma unroll
                    for (int i = 0; i < 4; ++i) lg[(4 * (lane >> 4) + i) * 80 + 16 * t + (lane & 15)] = acc[t][i]; }
            LDS_WAIT(); asm volatile("" ::: "memory");
            if (lane < 8) { const LAS float* L = lg + lane * 80; const int rw = row0 + lane;
                float gm = L[0]; int gi = 0;
#pragma unroll
                for (int j = 1; j < 8; ++j) { const float v = L[j]; if (v > gm) { gm = v; gi = j; } }
                float den = 0.f;
#pragma unroll
                for (int j = 0; j < 8; ++j) den += expf(L[j] - gm);
                const float pg = 1.0f / den;
                const LAS float* E = L + 8 + 8 * gi; float v0 = E[0]; int i0 = 0;
#pragma unroll
                for (int j = 1; j < 8; ++j) { const float v = E[j]; if (v > v0) { v0 = v; i0 = j; } }
                float v1 = -INFINITY; int i1 = 0;
#pragma unroll
                for (int j = 0; j < 8; ++j) { const float v = E[j]; if (j != i0 && v > v1) { v1 = v; i1 = j; } }
                const float e1 = expf(v1 - v0), w0 = pg / (1.0f + e1), w1 = pg * e1 / (1.0f + e1);
                const int x0 = gi * 8 + i0, x1 = gi * 8 + i1;
                const int p0 = (int)atomicAdd(cnt + x0, 1u), p1 = (int)atomicAdd(cnt + x1, 1u);
                asg_e[2 * rw] = x0; asg_pos[2 * rw] = p0; asg_w[2 * rw] = w0; asg_e[2 * rw + 1] = x1; asg_pos[2 * rw + 1] = p1; asg_w[2 * rw + 1] = w1; }
            LDS_WAIT(); asm volatile("" ::: "memory");
        }
    }
}

__device__ __forceinline__ void phase_post_proj(unsigned char* ws, const float* g_cq, const float* g_ckv, const float* g_sbq, const float* g_sbk,
                                                const float* g_fq, const float* g_fk, int gw, int NGW, int lane) {
    for (int it = gw; it < 2 * NTOK; it += NGW) { const int which = it & 1, row = it >> 1;
        bf16* p = (bf16*)(ws + (which ? WS_CKV : WS_CQ)) + (size_t)row * 512 + 8 * lane; const float* g = (which ? g_ckv : g_cq) + 8 * lane;
        const v4u w = *(const GAS v4u*)p; float v[8] = {bflo(w.x), bfhi(w.x), bflo(w.y), bfhi(w.y), bflo(w.z), bfhi(w.z), bflo(w.w), bfhi(w.w)};
        float s = 0.f;
#pragma unroll
        for (int i = 0; i < 8; ++i) s += v[i] * v[i];
        const float r = 1.0f / sqrtf(wave_sum(s, lane) * (1.0f / 512.f) + EPS);
        v4u o; o.x = pk2(v[0] * r * g[0], v[1] * r * g[1]); o.y = pk2(v[2] * r * g[2], v[3] * r * g[3]); o.z = pk2(v[4] * r * g[4], v[5] * r * g[5]); o.w = pk2(v[6] * r * g[6], v[7] * r * g[7]);
        *(GAS v4u*)p = o; }
    for (int it = gw; it < 4 * NTOK; it += NGW) { const int which = it & 3, row = it >> 2; const int seg = (which & 1) + 3 * (which >> 1);
        bf16* p = (bf16*)(ws + WS_QKV6) + (size_t)seg * NTOK * 1024 + (size_t)row * 1024 + 16 * lane;
        const float* g = (which == 0 ? g_sbq : which == 1 ? g_sbk : which == 2 ? g_fq : g_fk) + 16 * (lane & 3);
        const float qs = (which & 1) ? 1.0f : 0.125f * LOG2E;
        const v4u w0 = *(const GAS v4u*)p, w1 = *(const GAS v4u*)(p + 8);
        float v[16] = {bflo(w0.x), bfhi(w0.x), bflo(w0.y), bfhi(w0.y), bflo(w0.z), bfhi(w0.z), bflo(w0.w), bfhi(w0.w), bflo(w1.x), bfhi(w1.x), bflo(w1.y), bfhi(w1.y), bflo(w1.z), bfhi(w1.z), bflo(w1.w), bfhi(w1.w)};
        float s = 0.f;
#pragma unroll
        for (int i = 0; i < 16; ++i) s += v[i] * v[i];
        s += bperm_xor(s, 1, lane); s += bperm_xor(s, 2, lane);
        const float r = qs / sqrtf(s * (1.0f / 64.f) + EPS);
        v4u o0, o1; o0.x = pk2(v[0] * r * g[0], v[1] * r * g[1]); o0.y = pk2(v[2] * r * g[2], v[3] * r * g[3]); o0.z = pk2(v[4] * r * g[4], v[5] * r * g[5]); o0.w = pk2(v[6] * r * g[6], v[7] * r * g[7]);
        o1.x = pk2(v[8] * r * g[8], v[9] * r * g[9]); o1.y = pk2(v[10] * r * g[10], v[11] * r * g[11]); o1.z = pk2(v[12] * r * g[12], v[13] * r * g[13]); o1.w = pk2(v[14] * r * g[14], v[15] * r * g[15]);
        *(GAS v4u*)p = o0; *(GAS v4u*)(p + 8) = o1; }
}

__device__ __forceinline__ void phase_rope(unsigned char* ws, const int* positions, int tid_g, int nthr_g) {
    float* cs = (float*)(ws + WS_ROPE); float* sn = cs + (size_t)NTOK * 32;
    for (int i = tid_g; i < NTOK * 32; i += nthr_g) { const int row = i >> 5, j = i & 31; const float inv = powf(10000.0f, -(float)(2 * j) / 64.0f); const float ang = (float)positions[row] * inv;
        cs[i] = cosf(ang); sn[i] = sinf(ang); }
}
__device__ __forceinline__ void phase_cumsum(unsigned char* ws, const float* f_bias, LAS unsigned char* lds, int vcu, int G, int tid, int lane) {
    LAS float* wt = (LAS float*)lds;
    for (int seq = vcu; seq < NBATCH * NH; seq += G) { const int b = seq >> 4, h = seq & 15; const float* sk = (const float*)(ws + WS_SK) + (size_t)(b * SEQ + 8 * tid) * 80 + 64 + h; const float fb = f_bias[h];
        float v[8];
#pragma unroll
        for (int i = 0; i < 8; ++i) v[i] = sk[i * 80];
        float run = 0.f;
#pragma unroll
        for (int i = 0; i < 8; ++i) { run -= __builtin_amdgcn_logf(1.0f + __builtin_amdgcn_exp2f(-LOG2E * (v[i] + fb))); v[i] = run; }
        float inc = run;
#pragma unroll
        for (int o = 1; o < 64; o <<= 1) { const float t2 = bperm_up(inc, o, lane); if (lane >= o) inc += t2; }
        if (lane == 63) wt[tid >> 6] = inc;
        __syncthreads();
        float base = inc - run;
        for (int w = 0; w < (tid >> 6); ++w) base += wt[w];
        float* cf = (float*)(ws + WS_CUMF) + (size_t)seq * SEQ + 8 * tid;
        *(GAS f32x4*)cf = (f32x4){base + v[0], base + v[1], base + v[2], base + v[3]}; *(GAS f32x4*)(cf + 4) = (f32x4){base + v[4], base + v[5], base + v[6], base + v[7]};
        __syncthreads(); }
}

__device__ __forceinline__ void phase_mla_finalize(unsigned char* ws, const float* __restrict__ g_k, int gw, int NGW, int lane) {
    const int head = lane >> 2, c = lane & 3;
    const float* __restrict__ cs = (const float*)(ws + WS_ROPE); const float* __restrict__ sn = cs + (size_t)NTOK * 32; const float* __restrict__ sk = (const float*)(ws + WS_SK);
    bf16* KM = (bf16*)(ws + WS_KM); const bf16* __restrict__ KN = (const bf16*)(ws + WS_KNOPE);
    f32x4 gk[12];
#pragma unroll
    for (int i = 0; i < 8; ++i) gk[i] = *(const GAS f32x4*)(g_k + 32 * c + 4 * i);
#pragma unroll
    for (int i = 0; i < 2; ++i) { gk[8 + i] = *(const GAS f32x4*)(g_k + 128 + 8 * c + 4 * i); gk[10 + i] = *(const GAS f32x4*)(g_k + 160 + 8 * c + 4 * i); }
    for (int row0 = 2 * gw; row0 < NTOK; row0 += 2 * NGW) {
        v4u kw[2][4]; f32x4 cv[2][2], sv[2][2], kr[2][4];
#pragma unroll
        for (int q = 0; q < 2; ++q) { const int row = row0 + q; const bf16* kn = KN + (size_t)row * 2048 + head * 128 + 32 * c;
#pragma unroll
            for (int j = 0; j < 4; ++j) kw[q][j] = *(const GAS v4u*)(kn + 8 * j);
#pragma unroll
            for (int i = 0; i < 2; ++i) { cv[q][i] = *(const GAS f32x4*)(cs + (size_t)row * 32 + 8 * c + 4 * i); sv[q][i] = *(const GAS f32x4*)(sn + (size_t)row * 32 + 8 * c + 4 * i);
                kr[q][i] = *(const GAS f32x4*)(sk + (size_t)row * 80 + 8 * c + 4 * i); kr[q][2 + i] = *(const GAS f32x4*)(sk + (size_t)row * 80 + 32 + 8 * c + 4 * i); } }
        __builtin_amdgcn_sched_barrier(0);
#pragma unroll
        for (int q = 0; q < 2; ++q) { bf16* kb_ = KM + (size_t)(row0 + q) * 3072 + head * 192; float v[48];
#pragma unroll
            for (int j = 0; j < 4; ++j) { const v4u w = kw[q][j]; v[8 * j] = bflo(w.x); v[8 * j + 1] = bfhi(w.x); v[8 * j + 2] = bflo(w.y); v[8 * j + 3] = bfhi(w.y); v[8 * j + 4] = bflo(w.z); v[8 * j + 5] = bfhi(w.z); v[8 * j + 6] = bflo(w.w); v[8 * j + 7] = bfhi(w.w); }
#pragma unroll
            for (int i = 0; i < 8; ++i) { v[32 + i] = kr[q][i >> 2][i & 3]; v[40 + i] = kr[q][2 + (i >> 2)][i & 3]; }
            float s = 0.f;
#pragma unroll
            for (int i = 0; i < 48; ++i) s += v[i] * v[i];
            s += bperm_xor(s, 1, lane); s += bperm_xor(s, 2, lane);
            const float r = 1.0f / sqrtf(s * (1.0f / 192.f) + EPS);
#pragma unroll
            for (int j = 0; j < 4; ++j) { v4u o; const f32x4 g0 = gk[2 * j], g1 = gk[2 * j + 1]; const float* x = v + 8 * j;
                o.x = pk2(x[0] * r * g0[0], x[1] * r * g0[1]); o.y = pk2(x[2] * r * g0[2], x[3] * r * g0[3]); o.z = pk2(x[4] * r * g1[0], x[5] * r * g1[1]); o.w = pk2(x[6] * r * g1[2], x[7] * r * g1[3]);
                *(GAS v4u*)(kb_ + 32 * c + 8 * j) = o; }
            float o1[8], o2[8];
#pragma unroll
            for (int i = 0; i < 8; ++i) { const float x1 = v[32 + i] * r * gk[8 + (i >> 2)][i & 3], x2 = v[40 + i] * r * gk[10 + (i >> 2)][i & 3], cc = cv[q][i >> 2][i & 3], ss = sv[q][i >> 2][i & 3]; o1[i] = x1 * cc - x2 * ss; o2[i] = x2 * cc + x1 * ss; }
            v4u a, b2; a.x = pk2(o1[0], o1[1]); a.y = pk2(o1[2], o1[3]); a.z = pk2(o1[4], o1[5]); a.w = pk2(o1[6], o1[7]); b2.x = pk2(o2[0], o2[1]); b2.y = pk2(o2[2], o2[3]); b2.z = pk2(o2[4], o2[5]); b2.w = pk2(o2[6], o2[7]);
            *(GAS v4u*)(kb_ + 128 + 8 * c) = a; *(GAS v4u*)(kb_ + 160 + 8 * c) = b2; }
        __builtin_amdgcn_sched_barrier(0);
    }
}

__device__ __forceinline__ void phase_route(unsigned char* ws, unsigned* cnt, LAS unsigned char* lds, int gw, int NGW, int wave, int lane) {
    const bf16* H = (const bf16*)(ws + WS_XN); const bf16* WRT = (const bf16*)(ws + WS_WRT);
    int* asg_e = (int*)(ws + WS_ASG); int* asg_pos = asg_e + NASG; float* asg_w = (float*)(asg_pos + NASG);
    LAS float* lg = (LAS float*)(lds + wave * 8192);
    for (int rg = gw; rg < NTOK / 16; rg += NGW) { f32x4 acc[5]; skinny16x80(H, WRT, rg * 16, lane, acc);
#pragma unroll
        for (int t = 0; t < 5; ++t)
#pragma unroll
            for (int i = 0; i < 4; ++i) lg[(4 * (lane >> 4) + i) * 80 + 16 * t + (lane & 15)] = acc[t][i];
        LDS_WAIT(); asm volatile("" ::: "memory");
        if (lane < 16) { const LAS float* L = lg + lane * 80; const int row = rg * 16 + lane;
            float gm = L[0]; int gi = 0;
#pragma unroll
            for (int j = 1; j < 8; ++j) { const float v = L[j]; if (v > gm) { gm = v; gi = j; } }
            float den = 0.f;
#pragma unroll
            for (int j = 0; j < 8; ++j) den += expf(L[j] - gm);
            const float pg = 1.0f / den;
            const LAS float* E = L + 8 + 8 * gi; float v0 = E[0]; int i0 = 0;
#pragma unroll
            for (int j = 1; j < 8; ++j) { const float v = E[j]; if (v > v0) { v0 = v; i0 = j; } }
            float v1 = -INFINITY; int i1 = 0;
#pragma unroll
            for (int j = 0; j < 8; ++j) { const float v = E[j]; if (j != i0 && v > v1) { v1 = v; i1 = j; } }
            const float e1 = expf(v1 - v0), w0 = pg / (1.0f + e1), w1 = pg * e1 / (1.0f + e1);
            const int x0 = gi * 8 + i0, x1 = gi * 8 + i1;
            const int p0 = (int)atomicAdd(cnt + x0, 1u), p1 = (int)atomicAdd(cnt + x1, 1u);
            asg_e[2 * row] = x0; asg_pos[2 * row] = p0; asg_w[2 * row] = w0; asg_e[2 * row + 1] = x1; asg_pos[2 * row + 1] = p1; asg_w[2 * row + 1] = w1; }
        LDS_WAIT(); asm volatile("" ::: "memory");
    }
}

__device__ __forceinline__ void phase_dispatch(unsigned char* ws, const unsigned* cnt, LAS unsigned char* lds, int gw, int NGW, int tid, int lane, int block) {
    LAS int* off = (LAS int*)lds;
    LAS int* cl = off + 72;
    if (tid < NEXP) cl[tid] = (int)__hip_atomic_load(cnt + tid, __ATOMIC_RELAXED, __HIP_MEMORY_SCOPE_AGENT);
    __syncthreads();
    if (tid == 0) { int a = 0; for (int e = 0; e < NEXP; ++e) { off[e] = a; a += ((cl[e] + 255) >> 8) << 8; } off[NEXP] = a; }
    __syncthreads();
    int* tile_e = (int*)(ws + WS_TAB); int* nrt_p = tile_e + 256;
    if (block == 0) { const int nrt = off[NEXP] >> 8; if (tid == 0) *nrt_p = nrt;
        for (int R = tid; R < nrt; R += NWAVES * 64) { int e = 0; while (e < NEXP - 1 && off[e + 1] <= 256 * R) ++e; tile_e[R] = e; }
        if (tid < NEXP) tile_e[400 + tid] = off[tid] >> 8;
        if (tid < 8) { int a = 0; for (int k = 0; k < 8; ++k) { tile_e[320 + 9 * tid + k] = a; a += (off[tid + 8 * k + 1] - off[tid + 8 * k]) >> 8; } tile_e[320 + 9 * tid + 8] = a; } }
    const int* asg_e = (const int*)(ws + WS_ASG); const int* asg_pos = asg_e + NASG; const float* asg_w = (const float*)(asg_pos + NASG);
    int* tslot = (int*)(asg_w + NASG); float* slot_w = (float*)(tslot + NASG); float* slot_r = slot_w + MAXSLOT; const float* RS2 = (const float*)(ws + WS_RS2);
    const bf16* H = (const bf16*)(ws + WS_XN); bf16* HS = (bf16*)(ws + WS_HS);
    for (int tok = 4 * gw; tok < NTOK; tok += 4 * NGW) {
        int sl[4][2]; v4u rv[4][4];
        { const v4u e0 = *(const GAS v4u*)(asg_e + 2 * tok), e1 = *(const GAS v4u*)(asg_e + 2 * tok + 4), p0 = *(const GAS v4u*)(asg_pos + 2 * tok), p1 = *(const GAS v4u*)(asg_pos + 2 * tok + 4);
          const unsigned ev[8] = {e0.x, e0.y, e0.z, e0.w, e1.x, e1.y, e1.z, e1.w}, pv[8] = {p0.x, p0.y, p0.z, p0.w, p1.x, p1.y, p1.z, p1.w};
#pragma unroll
          for (int a = 0; a < 8; ++a) sl[a >> 1][a & 1] = off[__builtin_amdgcn_readfirstlane((int)ev[a])] + __builtin_amdgcn_readfirstlane((int)pv[a]); }
#pragma unroll
        for (int q = 0; q < 4; ++q) { const GAS v4u* s = (const GAS v4u*)(H + (size_t)(tok + q) * DM) + lane;
#pragma unroll
            for (int j = 0; j < 4; ++j) rv[q][j] = __builtin_nontemporal_load(s + 64 * j); }
        __builtin_amdgcn_sched_barrier(0);
#pragma unroll
        for (int q = 0; q < 4; ++q)
#pragma unroll
            for (int k = 0; k < 2; ++k) { GAS v4u* d = (GAS v4u*)(HS + (size_t)sl[q][k] * DM) + lane;
#pragma unroll
                for (int j = 0; j < 4; ++j) d[64 * j] = rv[q][j];
                if (lane == 0) { const int a = 2 * (tok + q) + k; slot_w[sl[q][k]] = asg_w[a]; slot_r[sl[q][k]] = RS2[tok + q]; tslot[a] = sl[q][k]; } }
        __builtin_amdgcn_sched_barrier(0); }
    __syncthreads();
}

__device__ __forceinline__ void phase_combine(unsigned char* ws, const bf16* xs, float* x, int gw, int NGW, int lane) {
    const int* tslot = (const int*)(ws + WS_ASG) + 3 * NASG; const bf16* Y = (const bf16*)(ws + WS_Y);
    for (int row = 2 * gw; row < NTOK; row += 2 * NGW) { const v4u sv = *(const GAS v4u*)(tslot + 2 * row);
        const int s[4] = {__builtin_amdgcn_readfirstlane((int)sv.x), __builtin_amdgcn_readfirstlane((int)sv.y), __builtin_amdgcn_readfirstlane((int)sv.z), __builtin_amdgcn_readfirstlane((int)sv.w)};
        v2u ya[2][8], yb[2][8], xv[2][8];
#pragma unroll
        for (int q = 0; q < 2; ++q) { const GAS v2u* y0 = (const GAS v2u*)(Y + (size_t)s[2 * q] * DM) + lane; const GAS v2u* y1 = (const GAS v2u*)(Y + (size_t)s[2 * q + 1] * DM) + lane; const GAS v2u* xr = (const GAS v2u*)(xs + (size_t)(row + q) * DM) + lane;
#pragma unroll
            for (int j = 0; j < 8; ++j) { ya[q][j] = __builtin_nontemporal_load(y0 + 64 * j); yb[q][j] = __builtin_nontemporal_load(y1 + 64 * j); xv[q][j] = __builtin_nontemporal_load(xr + 64 * j); } }
        __builtin_amdgcn_sched_barrier(0);
#pragma unroll
        for (int q = 0; q < 2; ++q) { GAS f32x4* xr = (GAS f32x4*)(x + (size_t)(row + q) * DM) + lane;
#pragma unroll
            for (int j = 0; j < 8; ++j) { const v2u a = ya[q][j], b = yb[q][j], c = xv[q][j]; f32x4 v;
                v.x = bflo(c.x) + (bflo(a.x) + bflo(b.x)); v.y = bfhi(c.x) + (bfhi(a.x) + bfhi(b.x)); v.z = bflo(c.y) + (bflo(a.y) + bflo(b.y)); v.w = bfhi(c.y) + (bfhi(a.y) + bfhi(b.y)); __builtin_nontemporal_store(v, xr + 64 * j); } }
        __builtin_amdgcn_sched_barrier(0); }
}
__device__ __forceinline__ int crow(int r, int hi) { return (r & 3) + 8 * (r >> 2) + 4 * hi; }
template <int DK, int DV, int MODE>
__device__ __forceinline__ void attn_unit(LAS unsigned char* lds, const bf16* Qg, const bf16* Kg, const bf16* Vg, bf16* Og, int pqk, int pv, int b, int h, int qb, const float* ckg, float sbound, const float* gq = nullptr, const float* rope = nullptr) {
    constexpr int KST = DK * 2 + 16, VST = DV * 2 + 64;
    constexpr int KBYTES = 64 * KST, VBYTES = 64 * VST, STAGE = KBYTES + VBYTES + 256;
    constexpr int KCH = DK / 8, VCH = DV / 8, NKL = 64 * KCH / 512, NVL = 64 * VCH / 512;
    static_assert(2 * STAGE <= RING_BYTES, "attention LDS");
    int tid_ = threadIdx.x; asm volatile("" : "+v"(tid_));
    const int tid = tid_, lane = tid & 63, r32 = lane & 31, hi = lane >> 5; const int wid = __builtin_amdgcn_readfirstlane(tid >> 6);
    const size_t rowbase = (size_t)b * SEQ; const int q0 = qb * 256;
    bf16x8 qr[DK / 16];
    { const bf16* qp = Qg + (rowbase + q0 + wid * 32 + r32) * pqk + h * DK + 8 * hi;
#pragma unroll
      for (int d0 = 0; d0 < DK / 16; ++d0) qr[d0] = *(const GAS bf16x8*)(qp + 16 * d0); }
    if (DK == 192) {
        float qf[12][8]; float ss = 0.f;
#pragma unroll
        for (int d0 = 0; d0 < 12; ++d0) { const v4u w = __builtin_bit_cast(v4u, qr[d0]);
            qf[d0][0] = bflo(w.x); qf[d0][1] = bfhi(w.x); qf[d0][2] = bflo(w.y); qf[d0][3] = bfhi(w.y); qf[d0][4] = bflo(w.z); qf[d0][5] = bfhi(w.z); qf[d0][6] = bflo(w.w); qf[d0][7] = bfhi(w.w);
#pragma unroll
            for (int j = 0; j < 8; ++j) ss += qf[d0][j] * qf[d0][j]; }
        { auto rr = __builtin_amdgcn_permlane32_swap(__float_as_uint(ss), __float_as_uint(ss), false, false); ss = __uint_as_float(rr[0]) + __uint_as_float(rr[1]); }
        const float rn = (0.07216878364870322f * LOG2E) / sqrtf(ss * (1.0f / 192.f) + EPS);
        const float* gp = gq + 8 * hi; const float* cs = rope + (size_t)(rowbase + q0 + wid * 32 + r32) * 32 + 8 * hi; const float* sn = cs + (size_t)NTOK * 32;
#pragma unroll
        for (int d0 = 0; d0 < 8; ++d0) { const f32x4 g0 = *(const GAS f32x4*)(gp + 16 * d0), g1 = *(const GAS f32x4*)(gp + 16 * d0 + 4); v4u w;
            w.x = pk2(qf[d0][0] * rn * g0[0], qf[d0][1] * rn * g0[1]); w.y = pk2(qf[d0][2] * rn * g0[2], qf[d0][3] * rn * g0[3]); w.z = pk2(qf[d0][4] * rn * g1[0], qf[d0][5] * rn * g1[1]); w.w = pk2(qf[d0][6] * rn * g1[2], qf[d0][7] * rn * g1[3]);
            qr[d0] = __builtin_bit_cast(bf16x8, w); }
#pragma unroll
        for (int d0 = 8; d0 < 10; ++d0) { const f32x4 ga0 = *(const GAS f32x4*)(gp + 16 * d0), ga1 = *(const GAS f32x4*)(gp + 16 * d0 + 4), gb0 = *(const GAS f32x4*)(gp + 16 * d0 + 32), gb1 = *(const GAS f32x4*)(gp + 16 * d0 + 36);
            const f32x4 c0 = *(const GAS f32x4*)(cs + 16 * (d0 - 8)), c1 = *(const GAS f32x4*)(cs + 16 * (d0 - 8) + 4), s0 = *(const GAS f32x4*)(sn + 16 * (d0 - 8)), s1 = *(const GAS f32x4*)(sn + 16 * (d0 - 8) + 4);
            float o1[8], o2[8];
#pragma unroll
            for (int j = 0; j < 8; ++j) { const float x1 = qf[d0][j] * rn * (j < 4 ? ga0[j & 3] : ga1[j & 3]), x2 = qf[d0 + 2][j] * rn * (j < 4 ? gb0[j & 3] : gb1[j & 3]), cc = (j < 4 ? c0[j & 3] : c1[j & 3]), sv = (j < 4 ? s0[j & 3] : s1[j & 3]);
                o1[j] = x1 * cc - x2 * sv; o2[j] = x2 * cc + x1 * sv; }
            v4u wa, wb; wa.x = pk2(o1[0], o1[1]); wa.y = pk2(o1[2], o1[3]); wa.z = pk2(o1[4], o1[5]); wa.w = pk2(o1[6], o1[7]); wb.x = pk2(o2[0], o2[1]); wb.y = pk2(o2[2], o2[3]); wb.z = pk2(o2[4], o2[5]); wb.w = pk2(o2[6], o2[7]);
            qr[d0] = __builtin_bit_cast(bf16x8, wa); qr[d0 + 2] = __builtin_bit_cast(bf16x8, wb); }
    }
    f32x16 o[DV / 32];
#pragma unroll
    for (int i = 0; i < DV / 32; ++i) o[i] = (f32x16){};
    float mrun = -INFINITY, lrun = 0.f, Rrun = 0.f;
    bf16x8 utri[2], uone;
    if (MODE == 2) {
#pragma unroll
        for (int s = 0; s < 2; ++s)
#pragma unroll
            for (int j = 0; j < 8; ++j) { const int key = 16 * s + 8 * (j >> 2) + 4 * hi + (j & 3); utri[s][j] = (short)(key >= r32 ? 0x3F80 : 0); }
#pragma unroll
        for (int j = 0; j < 8; ++j) uone[j] = (short)0x3F80;
    }
    const int NT = 4 * qb + 4;
    v4u kreg[NKL], vreg[NVL]; float ckreg = 0.f;
    const bf16* Kh = Kg + rowbase * pqk + h * DK; const bf16* Vh = Vg + rowbase * pv + h * DV; const float* ckh = (MODE == 1) ? ckg + (size_t)(b * NH + h) * SEQ : nullptr;
#define ATT_LOAD(kt) do { \
        _Pragma("unroll") for (int i = 0; i < NKL; ++i) { const int c = tid + 512 * i, row = c / KCH, cc = c % KCH; kreg[i] = *(const GAS v4u*)(Kh + (size_t)((kt) * 64 + row) * pqk + cc * 8); } \
        _Pragma("unroll") for (int i = 0; i < NVL; ++i) { const int c = tid + 512 * i, row = c / VCH, cc = c % VCH; vreg[i] = *(const GAS v4u*)(Vh + (size_t)((kt) * 64 + row) * pv + cc * 8); } \
        if (MODE == 1 && tid < 64) ckreg = ckh[(kt) * 64 + tid]; } while (0)
#define ATT_STORE(st) do { \
        _Pragma("unroll") for (int i = 0; i < NKL; ++i) { const int c = tid + 512 * i, row = c / KCH, cc = c % KCH; *(LAS v4u*)((st) + row * KST + cc * 16) = kreg[i]; } \
        _Pragma("unroll") for (int i = 0; i < NVL; ++i) { const int c = tid + 512 * i, row = c / VCH, cc = c % VCH; *(LAS v4u*)((st) + KBYTES + row * VST + cc * 16) = vreg[i]; } \
        if (MODE == 1 && tid < 64) *(LAS float*)((st) + KBYTES + VBYTES + tid * 4) = ckreg; } while (0)
    ATT_LOAD(NT - 1); ATT_STORE(lds); __syncthreads();
    const int qrel = wid * 32 + r32;
    for (int it = 0; it < NT; ++it) {
        const int kt = NT - 1 - it; LAS unsigned char* st = lds + (it & 1) * STAGE; LAS unsigned char* stn = lds + ((it & 1) ^ 1) * STAGE;
        if (it + 1 < NT) ATT_LOAD(kt - 1);
        float cknext = 0.f; if (MODE == 1 && it + 1 < NT) cknext = ckh[(kt - 1) * 64 + 63];
        const int jb = kt - 4 * qb;
        if (!(jb >= 0 && 2 * jb > wid)) {
            f32x16 p0 = (f32x16){}, p1 = (f32x16){};
            {
              const LAS unsigned char* kb = st + r32 * KST + hi * 16;
              constexpr int NF = 2 * (DK / 16), FB = 4; bf16x8 kf[2][FB];
#pragma unroll
              for (int i = 0; i < FB; ++i) kf[0][i] = *(const LAS bf16x8*)(kb + (i & 1) * 32 * KST + (i >> 1) * 32);
#pragma unroll
              for (int bq = 0; bq < NF / FB; ++bq) {
                  if (bq + 1 < NF / FB) {
#pragma unroll
                      for (int i = 0; i < FB; ++i) { const int f = (bq + 1) * FB + i; kf[(bq + 1) & 1][i] = *(const LAS bf16x8*)(kb + (f & 1) * 32 * KST + (f >> 1) * 32); } }
                  __builtin_amdgcn_sched_barrier(0); __builtin_amdgcn_s_setprio(1);
#pragma unroll
                  for (int i = 0; i < FB; ++i) { const int f = bq * FB + i;
                      if (f & 1) p1 = __builtin_amdgcn_mfma_f32_32x32x16_bf16(kf[bq & 1][i], qr[f >> 1], p1, 0, 0, 0);
                      else p0 = __builtin_amdgcn_mfma_f32_32x32x16_bf16(kf[bq & 1][i], qr[f >> 1], p0, 0, 0, 0); }
                  __builtin_amdgcn_s_setprio(0); __builtin_amdgcn_sched_barrier(0); } }
            if (MODE != 2) {
                if (MODE == 1) { const LAS float* cks = (const LAS float*)(st + KBYTES + VBYTES);
#pragma unroll
                    for (int g = 0; g < 4; ++g) { const f32x4 c0 = *(const LAS f32x4*)(cks + 8 * g + 4 * hi), c1 = *(const LAS f32x4*)(cks + 32 + 8 * g + 4 * hi);
#pragma unroll
                        for (int i = 0; i < 4; ++i) { p0[4 * g + i] -= c0[i]; p1[4 * g + i] -= c1[i]; } } }
                if (jb >= 0) {
#pragma unroll
                    for (int r = 0; r < 16; ++r) { const int kv = 64 * jb + crow(r, hi); if (kv > qrel) p0[r] = -INFINITY; if (kv + 32 > qrel) p1[r] = -INFINITY; } }
                float mx = p0[0];
#pragma unroll
                for (int r = 1; r < 16; ++r) mx = fmaxf(mx, p0[r]);
#pragma unroll
                for (int r = 0; r < 16; ++r) mx = fmaxf(mx, p1[r]);
                { auto rr = __builtin_amdgcn_permlane32_swap(__float_as_uint(mx), __float_as_uint(mx), false, false); mx = fmaxf(__uint_as_float(rr[0]), __uint_as_float(rr[1])); }
                if (__any(mx - mrun > 8.0f)) { const float mnew = fmaxf(mrun, mx), alpha = __builtin_amdgcn_exp2f(mrun - mnew); mrun = mnew; lrun *= alpha;
#pragma unroll
                    for (int i = 0; i < DV / 32; ++i) o[i] *= alpha; }
                float sum = 0.f;
#pragma unroll
                for (int r = 0; r < 16; ++r) { p0[r] = __builtin_amdgcn_exp2f(p0[r] - mrun); p1[r] = __builtin_amdgcn_exp2f(p1[r] - mrun); sum += p0[r] + p1[r]; }
                lrun += sum;
            } else {
                f32x16 l0, l1;
#pragma unroll
                for (int r = 0; r < 16; ++r) { l0[r] = __builtin_amdgcn_logf(1.0f + __builtin_amdgcn_exp2f(p0[r])); l1[r] = __builtin_amdgcn_logf(1.0f + __builtin_amdgcn_exp2f(p1[r])); }
                if (jb >= 0) {
#pragma unroll
                    for (int r = 0; r < 16; ++r) { const int kv = 64 * jb + crow(r, hi); if (kv >= qrel) l0[r] = 0.f; if (kv + 32 >= qrel) l1[r] = 0.f; } }
                v4u lb[4];
#pragma unroll
                for (int s = 0; s < 2; ++s) { lb[s].x = pg8::cvt_pk_bf16(l0[8 * s], l0[8 * s + 1]); lb[s].y = pg8::cvt_pk_bf16(l0[8 * s + 2], l0[8 * s + 3]); lb[s].z = pg8::cvt_pk_bf16(l0[8 * s + 4], l0[8 * s + 5]); lb[s].w = pg8::cvt_pk_bf16(l0[8 * s + 6], l0[8 * s + 7]);
                    lb[2 + s].x = pg8::cvt_pk_bf16(l1[8 * s], l1[8 * s + 1]); lb[2 + s].y = pg8::cvt_pk_bf16(l1[8 * s + 2], l1[8 * s + 3]); lb[2 + s].z = pg8::cvt_pk_bf16(l1[8 * s + 4], l1[8 * s + 5]); lb[2 + s].w = pg8::cvt_pk_bf16(l1[8 * s + 6], l1[8 * s + 7]); }
                f32x16 c0, c1;
#pragma unroll
                for (int r = 0; r < 16; ++r) { c0[r] = Rrun; c1[r] = Rrun; }
                c0 = __builtin_amdgcn_mfma_f32_32x32x16_bf16(utri[0], __builtin_bit_cast(bf16x8, lb[0]), c0, 0, 0, 0);
                c0 = __builtin_amdgcn_mfma_f32_32x32x16_bf16(utri[1], __builtin_bit_cast(bf16x8, lb[1]), c0, 0, 0, 0);
                c0 = __builtin_amdgcn_mfma_f32_32x32x16_bf16(uone, __builtin_bit_cast(bf16x8, lb[2]), c0, 0, 0, 0);
                c0 = __builtin_amdgcn_mfma_f32_32x32x16_bf16(uone, __builtin_bit_cast(bf16x8, lb[3]), c0, 0, 0, 0);
                c1 = __builtin_amdgcn_mfma_f32_32x32x16_bf16(utri[0], __builtin_bit_cast(bf16x8, lb[2]), c1, 0, 0, 0);
                c1 = __builtin_amdgcn_mfma_f32_32x32x16_bf16(utri[1], __builtin_bit_cast(bf16x8, lb[3]), c1, 0, 0, 0);
#pragma unroll
                for (int r = 0; r < 16; ++r) { p0[r] = __builtin_amdgcn_exp2f(p0[r] - c0[r]); p1[r] = __builtin_amdgcn_exp2f(p1[r] - c1[r]); }
                if (jb >= 0) {
#pragma unroll
                    for (int r = 0; r < 16; ++r) { const int kv = 64 * jb + crow(r, hi); if (kv >= qrel) p0[r] = 0.f; if (kv + 32 >= qrel) p1[r] = 0.f; } }
                { auto rr = __builtin_amdgcn_permlane32_swap(__float_as_uint(c0[0]), __float_as_uint(c0[0]), false, false); Rrun = __uint_as_float(rr[0]); }
            }
            v4u pb[4];
#pragma unroll
            for (int s = 0; s < 2; ++s) { pb[s].x = pg8::cvt_pk_bf16(p0[8 * s], p0[8 * s + 1]); pb[s].y = pg8::cvt_pk_bf16(p0[8 * s + 2], p0[8 * s + 3]); pb[s].z = pg8::cvt_pk_bf16(p0[8 * s + 4], p0[8 * s + 5]); pb[s].w = pg8::cvt_pk_bf16(p0[8 * s + 6], p0[8 * s + 7]);
                pb[2 + s].x = pg8::cvt_pk_bf16(p1[8 * s], p1[8 * s + 1]); pb[2 + s].y = pg8::cvt_pk_bf16(p1[8 * s + 2], p1[8 * s + 3]); pb[2 + s].z = pg8::cvt_pk_bf16(p1[8 * s + 4], p1[8 * s + 5]); pb[2 + s].w = pg8::cvt_pk_bf16(p1[8 * s + 6], p1[8 * s + 7]); }
            {
              const LAS unsigned char* vb = st + KBYTES + (4 * hi + ((lane & 15) >> 2)) * VST + ((lane >> 4) & 1) * 32 + (lane & 3) * 8;
              constexpr int NBLK = DV / 32, NP = NBLK * 4, PB = 4; s16x4 vt[2][PB][2];
#define ATT_VRD(buf, g) do { const LAS unsigned char* vp_ = vb + (16 * ((g) / NBLK)) * VST + ((g) % NBLK) * 64; \
                  vt[buf][(g) % PB][0] = __builtin_bit_cast(s16x4, __builtin_amdgcn_ds_read_tr16_b64_v4i16((LAS s16x4*)vp_)); \
                  vt[buf][(g) % PB][1] = __builtin_bit_cast(s16x4, __builtin_amdgcn_ds_read_tr16_b64_v4i16((LAS s16x4*)(vp_ + 8 * VST))); } while (0)
#pragma unroll
              for (int i = 0; i < PB; ++i) ATT_VRD(0, i);
#pragma unroll
              for (int bq = 0; bq < NP / PB; ++bq) {
                  if (bq + 1 < NP / PB) {
#pragma unroll
                      for (int i = 0; i < PB; ++i) ATT_VRD((bq + 1) & 1, (bq + 1) * PB + i); }
                  __builtin_amdgcn_sched_barrier(0); __builtin_amdgcn_s_setprio(1);
#pragma unroll
                  for (int i = 0; i < PB; ++i) { const int g = bq * PB + i; const s16x4 t0 = vt[bq & 1][i][0], t1 = vt[bq & 1][i][1];
                      const bf16x8 af = (bf16x8){t0[0], t0[1], t0[2], t0[3], t1[0], t1[1], t1[2], t1[3]};
                      o[g % NBLK] = __builtin_amdgcn_mfma_f32_32x32x16_bf16(af, __builtin_bit_cast(bf16x8, pb[g / NBLK]), o[g % NBLK], 0, 0, 0); }
                  __builtin_amdgcn_s_setprio(0); __builtin_amdgcn_sched_barrier(0); }
#undef ATT_VRD
            }
        }
        if (it + 1 < NT) ATT_STORE(stn);
        if (MODE == 2) {
            LAS unsigned* fl = (LAS unsigned*)(lds + RING_BYTES) + (it & 1) * 8;
            const bool wdone = __all(Rrun > 36.0f);
            if (lane == 0) fl[wid] = wdone ? 1u : 0u;
            __syncthreads();
            const v4u f0 = *(const LAS v4u*)fl, f1 = *(const LAS v4u*)(fl + 4);
            if ((f0.x & f0.y & f0.z & f0.w & f1.x & f1.y & f1.z & f1.w) != 0u) break;
        } else if (MODE == 1) {
            LAS unsigned* fl = (LAS unsigned*)(lds + RING_BYTES) + (it & 1) * 8;
            const bool wdone = __all(mrun - (sbound - cknext) > 36.0f);
            if (lane == 0) fl[wid] = wdone ? 1u : 0u;
            __syncthreads();
            const v4u f0 = *(const LAS v4u*)fl, f1 = *(const LAS v4u*)(fl + 4);
            if ((f0.x & f0.y & f0.z & f0.w & f1.x & f1.y & f1.z & f1.w) != 0u) break;
        } else __syncthreads();
    }
#undef ATT_LOAD
#undef ATT_STORE
    float inv = 1.0f;
    if (MODE != 2) { auto rr = __builtin_amdgcn_permlane32_swap(__float_as_uint(lrun), __float_as_uint(lrun), false, false); inv = 1.0f / (__uint_as_float(rr[0]) + __uint_as_float(rr[1])); }
    bf16* op = Og + (rowbase + q0 + wid * 32 + r32) * pv + h * DV + 4 * hi;
#pragma unroll
    for (int blk = 0; blk < DV / 32; ++blk)
#pragma unroll
        for (int g = 0; g < 4; ++g) { v2u w; w.x = pk2(o[blk][4 * g] * inv, o[blk][4 * g + 1] * inv); w.y = pk2(o[blk][4 * g + 2] * inv, o[blk][4 * g + 3] * inv); *(GAS v2u*)(op + 32 * blk + 8 * g) = w; }
}
struct Args { const void* in[25]; float* out; unsigned char* ws; int ph_lo, ph_hi; };
__global__ void __launch_bounds__(NWAVES * 64, 2) mk_fwd(Args args) {
    extern __shared__ __attribute__((aligned(16))) unsigned char lds_raw[];
    LAS unsigned char* lds = (LAS unsigned char*)lds_raw;
    volatile LAS unsigned* MISC = (volatile LAS unsigned*)(lds + MISC_OFF);
    const int G = gridDim.x, bx = blockIdx.x; const int vcu = (G % 8 == 0) ? (bx % 8) * (G / 8) + bx / 8 : bx;
    const int NGW = G * NWAVES, nthr_g = G * NWAVES * 64;
    unsigned char* ws = args.ws; gu32* ctl = (gu32*)(ws + WS_CTL);
    for (int u = threadIdx.x; u < (LDS_BYTES - LDSCTL_OFF) / 4; u += NWAVES * 64) ((LAS unsigned*)(lds + LDSCTL_OFF))[u] = 0u;
    __syncthreads();
    XcdBarrier bar = xcd_barrier_post((unsigned*)(ctl + CW_BAR), MISC + 8);
    const int lo = args.ph_lo, hi = args.ph_hi; int ph = 0;
#define PH_BEGIN if (lo <= ph && ph < hi) { int tid = threadIdx.x; asm volatile("" : "+v"(tid)); const int lane = tid & 63, wave = __builtin_amdgcn_readfirstlane(tid >> 6), gw = vcu * NWAVES + wave, tid_g = vcu * NWAVES * 64 + tid; (void)lane; (void)gw; (void)tid_g;
#define PH_END   if (ph + 1 < hi) xcd_barrier(bar); } ++ph;

#define XN ((bf16*)(ws + WS_XN))
#define CQ ((bf16*)(ws + WS_CQ))
#define CKV ((bf16*)(ws + WS_CKV))
#define QKV6 ((bf16*)(ws + WS_QKV6))
#define GATES ((bf16*)(ws + WS_GATES))
#define QM ((bf16*)(ws + WS_QM))
#define KM ((bf16*)(ws + WS_KM))
#define VM ((bf16*)(ws + WS_VM))
#define KNOPE ((bf16*)(ws + WS_KNOPE))
#define OA ((bf16*)(ws + WS_OA))
#define OB ((bf16*)(ws + WS_OB))
#define OC ((bf16*)(ws + WS_OC))
#define MF ((float*)(ws + WS_MF))
#define XOB ((bf16*)(ws + WS_MF))
#define XBB ((bf16*)(ws + WS_MF + 64 * MiB))
#define MB ((bf16*)(ws + WS_MB))
#define HS ((bf16*)(ws + WS_HS))
#define ACT ((bf16*)(ws + WS_ACT))
#define YB ((bf16*)(ws + WS_Y))
#define SEGS ((size_t)NTOK * 1024)
#define XSRC ((l == 0) ? (const float*)args.in[0] : (const float*)(ws + WS_XB))
#define XO (args.out)
#define POSITIONS ((const int*)args.in[1])

#pragma unroll 1
    for (int l = 0; l < DEPTH; ++l) {
        PH_BEGIN
            if (l == 0) {
                for (int l2 = 0; l2 < DEPTH; ++l2)
                    phase_convert_small((const float*)args.in[3] + (size_t)l2 * 2048 * DIN, (const float*)args.in[20] + (size_t)l2 * 2048 * 8, (const float*)args.in[21] + (size_t)l2 * 2048 * 64,
                                        (bf16*)(ws + WS_WSK) + (size_t)l2 * 80 * 2048, (bf16*)(ws + WS_WRT) + (size_t)l2 * 80 * 2048, tid_g, nthr_g);
                phase_rope(ws, POSITIONS, tid_g, nthr_g);
                if (tid_g < DEPTH * 256) { const int l2 = tid_g >> 8, wh = (tid_g >> 6) & 3, d = tid_g & 63;
                    ((float*)(ws + WS_GN))[tid_g] = ((const float*)args.in[10 + wh])[l2 * 64 + d]; }
            }
            ConvSrc S; S.w_in = (const float*)args.in[3] + (size_t)l * 2048 * DIN; S.w_uq = (const float*)args.in[5] + (size_t)l * 512 * 3072; S.w_ukv = (const float*)args.in[7] + (size_t)l * 512 * 4096;
            S.w_ba = (const float*)args.in[15] + (size_t)l * 2048 * 2048; S.w_bb = (const float*)args.in[16] + (size_t)l * 1024 * 2048; S.w_bc = (const float*)args.in[17] + (size_t)l * 1024 * 2048;
            S.w_out = (const float*)args.in[18] + (size_t)l * 2048 * 2048; S.g_cq = (const float*)args.in[4] + l * 512; S.g_ckv = (const float*)args.in[6] + l * 512;
            S.w_eg = (const float*)args.in[22] + (size_t)l * 64 * 2048 * 512; S.w_eu = (const float*)args.in[23] + (size_t)l * 64 * 2048 * 512; S.w_ed = (const float*)args.in[24] + (size_t)l * 64 * 512 * 2048;
            phase_convert(S, ws, gw, NGW, 7552, lane, lds + 65536 + wave * 9216);
            if (l == 0) xcd_barrier(bar);
            else { asm volatile("s_waitcnt vmcnt(0)" ::: "memory"); __syncthreads(); }
            if (l == 0) phase_norm_skinny<false, false>((const float*)args.in[0], nullptr, nullptr, nullptr, (const float*)args.in[2], (const bf16*)(ws + WS_WSK), XN, (float*)(ws + WS_RS), (float*)(ws + WS_SK), nullptr, nullptr, nullptr, nullptr, lds, gw, NGW, wave, lane, (const float*)args.in[9] + l * 192 + 128, (const float*)(ws + WS_ROPE), (float*)(ws + WS_KNOPE));
            if (l != 0) phase_norm_skinny<true, false, true>(XOB, XBB, YB, (const int*)(ws + WS_ASG) + 3 * NASG, (const float*)args.in[2] + l * DM, (const bf16*)(ws + WS_WSK) + (size_t)l * 80 * 2048, XN, (float*)(ws + WS_RS), (float*)(ws + WS_SK), nullptr, nullptr, nullptr, nullptr, lds, gw, NGW, wave, lane, (const float*)args.in[9] + l * 192 + 128, (const float*)(ws + WS_ROPE), (float*)(ws + WS_KNOPE));
        PH_END
        PH_BEGIN
            phase_cumsum(ws, (const float*)args.in[14] + l * 16, lds, vcu, G, tid, lane);
            { pg8::Gemm g{XN, (const bf16*)(ws + WS_WIN), NTOK, NBIG, DM}; pg8::StaticOrder S; S.init(NTOK, NBIG, G, bx);
              pg8::EpiSeg E{ws, (const float*)(ws + WS_GN) + l * 256};
              pg8::gemm_phase<pg8::EpiSeg, pg8::StaticOrder, true, true>(lds + RING_OFF, g, S, E); }
        PH_END
        PH_BEGIN
            { pg8::Gemm g{CQ, (const bf16*)(ws + WS_WUQ), NTOK, 3072, 512}; pg8::StaticOrder S; S.init(NTOK, 3072, G, bx); pg8::EpiPlain E{QM, 3072};
              pg8::gemm_phase<pg8::EpiPlain, pg8::StaticOrder, true, true>(lds + RING_OFF, g, S, E); }
            { pg8::Gemm g{CKV, (const bf16*)(ws + WS_WUKV), NTOK, 4096, 512}; pg8::StaticOrder S; S.init(NTOK, 4096, G, bx); pg8::EpiKF E{KM, VM, (const float*)(ws + WS_PART), (const float*)(ws + WS_KNOPE), (const float*)(ws + WS_SK), (const float*)args.in[9] + l * 192, (unsigned)(size_t)(lds + RING_BYTES + 2048)};
              pg8::gemm_phase<pg8::EpiKF, pg8::StaticOrder, true, true>(lds + RING_OFF, g, S, E); }
        PH_END
        PH_BEGIN
            { LAS unsigned* slot = (LAS unsigned*)(lds + RING_BYTES + 64);
#define ATT_QUEUE(QI, CALL) for (int dq_ = 0; dq_ < 8; ++dq_) { const int xq_ = (int)((bar.x + (unsigned)dq_) & 7u); \
                gu32* q_ = ctl + CW_AQ + ((l * 3 + (QI)) * 8 + xq_) * 64; \
                if (threadIdx.x == 0) *slot = __hip_atomic_fetch_add(q_, 1u, __ATOMIC_RELAXED, __HIP_MEMORY_SCOPE_AGENT); \
                __syncthreads(); unsigned cur = (unsigned)__builtin_amdgcn_readfirstlane((int)*slot); __syncthreads(); \
                while (cur < 128u) { unsigned nxt_ = 0u; if (threadIdx.x == 0) nxt_ = __hip_atomic_fetch_add(q_, 1u, __ATOMIC_RELAXED, __HIP_MEMORY_SCOPE_AGENT); \
                    const int qb = 15 - (int)((cur & 31u) >> 1), bh = (int)(2u * (cur >> 5) + (cur & 1u)) * 8 + xq_, b = bh >> 4, h = bh & 15; \
                    CALL; \
                    if (threadIdx.x == 0) *slot = nxt_; \
                    __syncthreads(); cur = (unsigned)__builtin_amdgcn_readfirstlane((int)*slot); __syncthreads(); } }
              for (int dq_ = 0; dq_ < 8; ++dq_) { const int xq_ = (int)((bar.x + (unsigned)dq_) & 7u);
                gu32* q_ = ctl + CW_AQ + ((l * 3 + 0) * 8 + xq_) * 64;
                if (threadIdx.x == 0) *slot = __hip_atomic_fetch_add(q_, 1u, __ATOMIC_RELAXED, __HIP_MEMORY_SCOPE_AGENT);
                __syncthreads(); unsigned cur = (unsigned)__builtin_amdgcn_readfirstlane((int)*slot); __syncthreads();
                while (cur < 176u) { unsigned nxt_ = 0u; if (threadIdx.x == 0) nxt_ = __hip_atomic_fetch_add(q_, 1u, __ATOMIC_RELAXED, __HIP_MEMORY_SCOPE_AGENT);
                    const unsigned grp = cur / 11u, pos = cur - grp * 11u;
                    if (pos == 3u || pos == 7u || pos == 10u) {
                        const int chunk = xq_ * 48 + (int)grp * 3 + (pos == 3u ? 0 : (pos == 7u ? 1 : 2));
                        conv_expert_items((const float*)args.in[22] + (size_t)l * 64 * 2048 * 512, (const float*)args.in[23] + (size_t)l * 64 * 2048 * 512, (const float*)args.in[24] + (size_t)l * 64 * 512 * 2048,
                                          (const float*)args.in[15] + (size_t)l * 2048 * 2048, (const float*)args.in[16] + (size_t)l * 1024 * 2048, (const float*)args.in[17] + (size_t)l * 1024 * 2048, (const float*)args.in[18] + (size_t)l * 2048 * 2048,
                                          ws, chunk * 128 + wave, chunk * 8 + wave, lds + 65536 + wave * 9216);
                    } else {
                        const unsigned u = grp * 8u + pos - (pos > 3u ? 1u : 0u) - (pos > 7u ? 1u : 0u);
                        const int qb = 15 - (int)((u & 31u) >> 1), bh = (int)(2u * (u >> 5) + (u & 1u)) * 8 + xq_, b = bh >> 4, h = bh & 15;
                        attn_unit<192, 128, 0>(lds, QM, KM, VM, OA, 3072, 2048, b, h, qb, nullptr, 0.f, (const float*)args.in[8] + l * 192, (const float*)(ws + WS_ROPE));
                    }
                    if (threadIdx.x == 0) *slot = nxt_;
                    __syncthreads(); cur = (unsigned)__builtin_amdgcn_readfirstlane((int)*slot); __syncthreads(); } }
              float fox_bound; { int t2_ = threadIdx.x; asm volatile("" : "+v"(t2_)); const int ln2 = t2_ & 63; const float gq = fabsf(((const float*)args.in[12])[l * 64 + ln2]), gk = fabsf(((const float*)args.in[13])[l * 64 + ln2]); float mq = gq, mk = gk;
#pragma unroll
                for (int o = 1; o < 64; o <<= 1) { mq = fmaxf(mq, bperm_xor(mq, o, ln2)); mk = fmaxf(mk, bperm_xor(mk, o, ln2)); }
                fox_bound = 8.0f * LOG2E * mq * mk * 1.03f; }
              ATT_QUEUE(1, (attn_unit<64, 64, 1>(lds, QKV6 + 3 * SEGS, QKV6 + 4 * SEGS, QKV6 + 5 * SEGS, OC, 1024, 1024, b, h, qb, (const float*)(ws + WS_CUMF), fox_bound)));
              ATT_QUEUE(2, (attn_unit<64, 64, 2>(lds, QKV6, QKV6 + SEGS, QKV6 + 2 * SEGS, OB, 1024, 1024, b, h, qb, nullptr, 0.f)));
#undef ATT_QUEUE
            }
        PH_END
        PH_BEGIN
            { pg8::Gemm g{OA, (const bf16*)(ws + WS_WBA), NTOK, DM, 2048}; pg8::StaticOrder S; S.init(NTOK, DM, G, bx); pg8::EpiMerge<0> E{GATES, MB};
              pg8::gemm_phase<pg8::EpiMerge<0>, pg8::StaticOrder, true, true>(lds + RING_OFF, g, S, E); }
            { pg8::Gemm g{OB, (const bf16*)(ws + WS_WBB), NTOK, DM, 1024}; pg8::StaticOrder S; S.init(NTOK, DM, G, bx); pg8::EpiMerge<1> E{GATES + 2048, MB};
              pg8::gemm_phase<pg8::EpiMerge<1>, pg8::StaticOrder, true, true>(lds + RING_OFF, g, S, E); }
            { pg8::Gemm g{OC, (const bf16*)(ws + WS_WBC), NTOK, DM, 1024}; pg8::StaticOrder S; S.init(NTOK, DM, G, bx); pg8::EpiMerge<2> E{GATES + 4096, MB};
              pg8::gemm_phase<pg8::EpiMerge<2>, pg8::StaticOrder, true, true>(lds + RING_OFF, g, S, E); }
        PH_END
        PH_BEGIN
            { pg8::Gemm g{MB, (const bf16*)(ws + WS_WOUT), NTOK, DM, 2048}; pg8::StaticOrder S; S.init(NTOK, DM, G, bx);
              if (l == 0) { pg8::EpiResidB<false> E{args.in[0], XOB}; pg8::gemm_phase<pg8::EpiResidB<false>, pg8::StaticOrder, true, true>(lds + RING_OFF, g, S, E); }
              else { pg8::EpiResidB<true> E{XBB, XOB}; pg8::gemm_phase<pg8::EpiResidB<true>, pg8::StaticOrder, true, true>(lds + RING_OFF, g, S, E); } }
        PH_END
        PH_BEGIN
            { int* asg_e = (int*)(ws + WS_ASG);
              phase_norm_skinny<false, true, true>(XOB, nullptr, nullptr, nullptr, (const float*)args.in[19] + l * DM, (const bf16*)(ws + WS_WRT) + (size_t)l * 80 * 2048, XN, (float*)(ws + WS_RS2), nullptr,
                                             (unsigned*)(ctl + CW_CNT + 64 * l), asg_e, asg_e + NASG, (float*)(asg_e + 2 * NASG), lds, gw, NGW, wave, lane); }
        PH_END
        PH_BEGIN
            phase_dispatch(ws, (const unsigned*)(ctl + CW_CNT + 64 * l), lds, gw, NGW, tid, lane, bx);
        PH_END
        PH_BEGIN
            { pg8::Gemm g{HS, (const bf16*)(ws + WS_WGU), MAXSLOT, NEXP * 1024, 2048}; pg8::MoeOrder S{(const int*)(ws + WS_TAB), 4, G, bx}; pg8::EpiSwiglu E{ACT, (const float*)(ws + WS_ASG) + 4 * NASG + MAXSLOT};
              pg8::gemm_phase<pg8::EpiSwiglu, pg8::MoeOrder, true, true>(lds + RING_OFF, g, S, E); }
        PH_END
        PH_BEGIN
            { pg8::Gemm g{ACT, (const bf16*)(ws + WS_WD), MAXSLOT, NEXP * 2048, 512}; pg8::MoeOrder S{(const int*)(ws + WS_TAB), 8, G, bx}; pg8::EpiDown E{YB, (const float*)(ws + WS_ASG) + 4 * NASG};
              pg8::gemm_phase<pg8::EpiDown, pg8::MoeOrder, true, true>(lds + RING_OFF, g, S, E); }
        PH_END
    }
    PH_BEGIN
        phase_combine(ws, XOB, XO, gw, NGW, lane);
    PH_END
#undef PH_BEGIN
#undef PH_END
}
constexpr int N_PHASES = 1 + 10 * DEPTH;

extern "C" void kernel_launch(void* const* d_in, const int* in_sizes, int n_in, void* d_out, int out_size, void* d_ws, size_t ws_size, hipStream_t stream) {
    static int grid = 0;
    if (grid == 0) {
        if (n_in != 25 || out_size != NTOK * DM || ws_size < WS_END) { fprintf(stderr, "kernel_launch: unexpected shapes (n_in %d out %d ws %zu need %zu); nothing launched\n", n_in, out_size, ws_size, (size_t)WS_END); grid = -1; return; }
        int dev = 0, cus = 0, per_cu = 0;
        if (hipGetDevice(&dev) != hipSuccess || hipDeviceGetAttribute(&cus, hipDeviceAttributeMultiprocessorCount, dev) != hipSuccess) { grid = -1; return; }
        if (hipFuncSetAttribute((const void*)mk_fwd, hipFuncAttributeMaxDynamicSharedMemorySize, LDS_BYTES) != hipSuccess) { fprintf(stderr, "kernel_launch: hipFuncSetAttribute failed\n"); grid = -1; return; }
        if (hipOccupancyMaxActiveBlocksPerMultiprocessor(&per_cu, (const void*)mk_fwd, NWAVES * 64, LDS_BYTES) != hipSuccess || per_cu < 1) { fprintf(stderr, "kernel_launch: occupancy query says %d blocks per CU\n", per_cu); }
        (void)hipGetLastError();
        grid = cus;
    }
    if (grid < 0) return;
    if (hipMemsetAsync((char*)d_ws + WS_CTL, 0, CTL_ZERO_BYTES, stream) != hipSuccess) { fprintf(stderr, "kernel_launch: memset failed\n"); return; }
    Args a{};
    for (int i = 0; i < 25; ++i) a.in[i] = d_in[i];
    a.out = (float*)d_out; a.ws = (unsigned char*)d_ws; a.ph_lo = 0; a.ph_hi = N_PHASES;
    hipLaunchKernelGGL(mk_fwd, dim3(grid), dim3(NWAVES * 64), LDS_BYTES, stream, a);
    const hipError_t le = hipPeekAtLastError();
    if (le != hipSuccess) fprintf(stderr, "kernel_launch: launch failed: %s\n", hipGetErrorName(le));
}
```

```cpp
#include <hip/hip_runtime.h>
#include <cstdio>
#include <cstdint>
#include <cmath>
namespace pg8 {
#define PG8_LAS __attribute__((address_space(3)))
typedef unsigned short bf16_t;
typedef short bf16x8 __attribute__((ext_vector_type(8)));
typedef float f32x4 __attribute__((ext_vector_type(4)));
typedef unsigned u32x4 __attribute__((ext_vector_type(4)));
constexpr int BM = 256, BK = 64, HALF = 128, HTB = HALF * BK * 2  , STAGE_BYTES = 8 * HTB, NXCD = 8, WGM = 4;

__host__ __device__ __forceinline__ int lds_byte(int r, int c) { const int st = (r >> 4) * 2 + (c >> 5), rr = r & 15, cc = c & 31, ob = rr * 64 + cc * 2; return st * 1024 + (ob ^ (((ob >> 9) & 1) << 5)); }
__host__ __device__ __forceinline__ void stage_rc(int b, int& R, int& C) { const int st = b / 1024, sb = b % 1024, swz = sb ^ (((sb >> 9) & 1) << 5); R = (st >> 1) * 16 + swz / 64; C = (st & 1) * 32 + (swz % 64) / 2; }
__host__ __device__ __forceinline__ int perm32(int rho) { const int n = rho >> 4, i = rho & 15; return 8 * (i >> 2) + 4 * n + (i & 3); }

struct Unit { int pm, pn; };
struct Gemm { const bf16_t* A; const bf16_t* Bt; int M, N, K; };

struct StaticOrder {
    int nM, nN, nwg, G, c, wgm;
    __host__ __device__ void init(int M, int N, int G_, int c_, int wgm_ = WGM) { nM = M / BM; nN = N / BM; nwg = nM * nN; G = G_; c = c_; wgm = wgm_; }
    __host__ __device__ bool next(int i, Unit& u) const {
        const long L = (long)i * G + c; if (L >= nwg) return false;
        int wgid = (int)L; { const int q = nwg / NXCD, r = nwg % NXCD, xcd = wgid % NXCD, off = wgid / NXCD; wgid = (xcd < r ? xcd * (q + 1) : r * (q + 1) + (xcd - r) * q) + off; }
        const int nig = wgm * nN, gid = wgid / nig, fm = gid * wgm, gsz = (nM - fm) < wgm ? (nM - fm) : wgm;
        u.pm = fm + ((wgid % nig) % gsz); u.pn = (wgid % nig) / gsz; return true;
    }
    __device__ __forceinline__ void a_ready(const Unit&) const {}
    __device__ __forceinline__ void done(const Unit&) const {}
};
__device__ __forceinline__ unsigned cvt_pk_bf16(float lo, float hi) { unsigned r; asm volatile("v_cvt_pk_bf16_f32 %0, %1, %2" : "=v"(r) : "v"(lo), "v"(hi)); return r; }
typedef float f32x2 __attribute__((ext_vector_type(2)));
typedef unsigned u32x2 __attribute__((ext_vector_type(2)));
__device__ __forceinline__ float bf2f(unsigned short b) { return __uint_as_float(((unsigned)b) << 16); }
__device__ __forceinline__ float bperm_xor(float v, int mask, int lane) { return __int_as_float(__builtin_amdgcn_ds_bpermute((lane ^ mask) << 2, __float_as_int(v))); }
__device__ __forceinline__ float sigmoidf_fast(float x) { return __builtin_amdgcn_rcpf(1.0f + __builtin_amdgcn_exp2f(-1.4426950408889634f * x)); }

struct EpiSeg {
    static constexpr bool PERM = true, AFTER_DRAIN = false;
    unsigned char* ws; const float* gn;
    static constexpr size_t O_CQ = 536ull << 20, O_CKV = 552ull << 20, O_QKV6 = 568ull << 20, O_GATES = 760ull << 20, O_PART = (1ull << 20) + 65536, O_RS = (1ull << 20) + 655360, SEG_BYTES = 16384ull * 1024 * 2;
    __device__ __forceinline__ void operator()(const f32x4 (&acc)[2][2][4][2], const Unit& u, int wr, int wc, int fr, int fq) const {
        const int pn = u.pn; bf16_t* base; int ldc, colt, kind = 0, gsel = 0;
        if (pn < 2) { base = (bf16_t*)(ws + O_CQ); ldc = 512; colt = 256 * pn; }
        else if (pn < 4) { base = (bf16_t*)(ws + O_CKV); ldc = 512; colt = 256 * (pn - 2); kind = 1; }
        else if (pn < 28) { const int s = (pn - 4) >> 2; base = (bf16_t*)(ws + O_QKV6 + (size_t)s * SEG_BYTES); ldc = 1024; colt = 256 * ((pn - 4) & 3);
            if (s != 2 && s != 5) { kind = 2; gsel = (s & 1) + (s >= 3 ? 2 : 0); } }
        else { base = (bf16_t*)(ws + O_GATES); ldc = 6144; colt = 256 * (pn - 28); }
        const int row0 = u.pm * BM + wr * 64 + fr;
        if (kind != 2) {
            const int col0 = colt + wc * 32 + 8 * fq;
#pragma unroll
            for (int ai = 0; ai < 2; ++ai) {
                float rs[4];
#pragma unroll
                for (int m = 0; m < 4; ++m) rs[m] = ((const float*)(ws + O_RS))[row0 + ai * HALF + m * 16];
                __builtin_amdgcn_sched_barrier(0);
#pragma unroll
                for (int m = 0; m < 4; ++m) { bf16_t* rowp = base + (size_t)(row0 + ai * HALF + m * 16) * ldc + col0;
#pragma unroll
                    for (int bj = 0; bj < 2; ++bj) { const f32x4 v0 = acc[ai][bj][m][0] * rs[m], v1 = acc[ai][bj][m][1] * rs[m];
                        u32x4 w; w.x = cvt_pk_bf16(v0[0], v0[1]); w.y = cvt_pk_bf16(v0[2], v0[3]); w.z = cvt_pk_bf16(v1[0], v1[1]); w.w = cvt_pk_bf16(v1[2], v1[3]);
                        *(u32x4*)(rowp + bj * HALF) = w; } }
                if (kind == 1) {
                    float* part = (float*)(ws + O_PART);
#pragma unroll
                    for (int m = 0; m < 4; ++m) { float s = 0.f;
#pragma unroll
                        for (int bj = 0; bj < 2; ++bj)
#pragma unroll
                            for (int n = 0; n < 2; ++n) { const f32x4 x = acc[ai][bj][m][n] * rs[m]; s += (x[0] * x[0] + x[1] * x[1]) + (x[2] * x[2] + x[3] * x[3]); }
                        { const int ln_ = fr | (fq << 4); s += bperm_xor(s, 16, ln_); s += bperm_xor(s, 32, ln_); }
                        if (fq == 0) part[(size_t)(row0 + ai * HALF + m * 16) * 8 + (pn - 2) * 4 + wc] = s; } }
                __builtin_amdgcn_sched_barrier(0); }
        } else {
            const float* g = gn + gsel * 64 + 8 * fq; const f32x4 ga0 = *(const f32x4*)g, ga1 = *(const f32x4*)(g + 4), gb0 = *(const f32x4*)(g + 32), gb1 = *(const f32x4*)(g + 36);
            const float qs = (gsel & 1) ? 1.0f : 0.125f * 1.4426950408889634f;
            const int col0 = colt + wc * 64 + 8 * fq;
#pragma unroll
            for (int ai = 0; ai < 2; ++ai)
#pragma unroll
                for (int m = 0; m < 4; ++m) { float s = 0.f;
#pragma unroll
                    for (int bj = 0; bj < 2; ++bj)
#pragma unroll
                        for (int n = 0; n < 2; ++n) { const f32x4 x = acc[ai][bj][m][n]; s += (x[0] * x[0] + x[1] * x[1]) + (x[2] * x[2] + x[3] * x[3]); }
                    { const int ln_ = fr | (fq << 4); s += bperm_xor(s, 16, ln_); s += bperm_xor(s, 32, ln_); }
                    const float r = qs * __builtin_amdgcn_rsqf(s * (1.0f / 64.f) + 1e-6f);
                    bf16_t* rowp = base + (size_t)(row0 + ai * HALF + m * 16) * ldc + col0;
                    { const f32x4 v0 = acc[ai][0][m][0] * ga0 * r, v1 = acc[ai][0][m][1] * ga1 * r;
                      u32x4 w; w.x = cvt_pk_bf16(v0[0], v0[1]); w.y = cvt_pk_bf16(v0[2], v0[3]); w.z = cvt_pk_bf16(v1[0], v1[1]); w.w = cvt_pk_bf16(v1[2], v1[3]); *(u32x4*)rowp = w; }
                    { const f32x4 v0 = acc[ai][1][m][0] * gb0 * r, v1 = acc[ai][1][m][1] * gb1 * r;
                      u32x4 w; w.x = cvt_pk_bf16(v0[0], v0[1]); w.y = cvt_pk_bf16(v0[2], v0[3]); w.z = cvt_pk_bf16(v1[0], v1[1]); w.w = cvt_pk_bf16(v1[2], v1[3]); *(u32x4*)(rowp + 32) = w; } }
        }
    }
};
struct EpiPlain {
    static constexpr bool PERM = true, AFTER_DRAIN = false;
    bf16_t* O; int ldc;
    __device__ __forceinline__ void operator()(const f32x4 (&acc)[2][2][4][2], const Unit& u, int wr, int wc, int fr, int fq) const {
        const int row0 = u.pm * BM + wr * 64 + fr, col0 = u.pn * BM + wc * 32 + 8 * fq;
#pragma unroll
        for (int ai = 0; ai < 2; ++ai)
#pragma unroll
            for (int m = 0; m < 4; ++m) { bf16_t* rowp = O + (size_t)(row0 + ai * HALF + m * 16) * ldc + col0;
#pragma unroll
                for (int bj = 0; bj < 2; ++bj) { const f32x4 v0 = acc[ai][bj][m][0], v1 = acc[ai][bj][m][1];
                    u32x4 w; w.x = cvt_pk_bf16(v0[0], v0[1]); w.y = cvt_pk_bf16(v0[2], v0[3]); w.z = cvt_pk_bf16(v1[0], v1[1]); w.w = cvt_pk_bf16(v1[2], v1[3]);
                    *(u32x4*)(rowp + bj * HALF) = w; } }
    }
};
struct EpiKV {
    static constexpr bool PERM = true, AFTER_DRAIN = false;
    bf16_t* KN; bf16_t* V; const float* part;
    __device__ __forceinline__ void operator()(const f32x4 (&acc)[2][2][4][2], const Unit& u, int wr, int wc, int fr, int fq) const {
        const int row0 = u.pm * BM + wr * 64 + fr, col0 = u.pn * 128 + wc * 32 + 8 * fq;
        f32x4 pav[2][4], pbv[2][4];
#pragma unroll
        for (int ai = 0; ai < 2; ++ai)
#pragma unroll
            for (int m = 0; m < 4; ++m) { const int rw = row0 + ai * HALF + m * 16; pav[ai][m] = *(const f32x4*)(part + (size_t)rw * 8); pbv[ai][m] = *(const f32x4*)(part + (size_t)rw * 8 + 4); }
        __builtin_amdgcn_sched_barrier(0);
#pragma unroll
        for (int ai = 0; ai < 2; ++ai)
#pragma unroll
            for (int m = 0; m < 4; ++m) { const int rw = row0 + ai * HALF + m * 16; const size_t off = (size_t)rw * 2048 + col0;
                const f32x4 pa = pav[ai][m], pb = pbv[ai][m];
                const float ssq = ((pa[0] + pa[1]) + (pa[2] + pa[3])) + ((pb[0] + pb[1]) + (pb[2] + pb[3]));
                const float r = __builtin_amdgcn_rsqf(ssq * (1.0f / 512.f) + 1e-6f);
#pragma unroll
                for (int bj = 0; bj < 2; ++bj) { const f32x4 v0 = acc[ai][bj][m][0] * r, v1 = acc[ai][bj][m][1] * r;
                    u32x4 w; w.x = cvt_pk_bf16(v0[0], v0[1]); w.y = cvt_pk_bf16(v0[2], v0[3]); w.z = cvt_pk_bf16(v1[0], v1[1]); w.w = cvt_pk_bf16(v1[2], v1[3]);
                    *(u32x4*)((bj == 0 ? KN : V) + off) = w; } }
    }
};
struct EpiKF {
    static constexpr bool PERM = true, AFTER_DRAIN = false;
    bf16_t* K; bf16_t* V; const float* part; const float* ssr; const float* kr; const float* gk; unsigned xch;
    __device__ __forceinline__ void operator()(const f32x4 (&acc)[2][2][4][2], const Unit& u, int wr, int wc, int fr, int fq) const {
        const int row0 = u.pm * BM + wr * 64 + fr, lane = fq * 16 + fr;
        PG8_LAS float* X = (PG8_LAS float*)(size_t)xch;
        float rc[2][4];
        { f32x4 pav[2][4], pbv[2][4];
#pragma unroll
          for (int ai = 0; ai < 2; ++ai)
#pragma unroll
            for (int m = 0; m < 4; ++m) { const int rw = row0 + ai * HALF + m * 16; pav[ai][m] = *(const f32x4*)(part + (size_t)rw * 8); pbv[ai][m] = *(const f32x4*)(part + (size_t)rw * 8 + 4); }
          __builtin_amdgcn_sched_barrier(0);
#pragma unroll
          for (int ai = 0; ai < 2; ++ai)
#pragma unroll
            for (int m = 0; m < 4; ++m) { const f32x4 pa = pav[ai][m], pb = pbv[ai][m];
                const float r = __builtin_amdgcn_rsqf((((pa[0] + pa[1]) + (pa[2] + pa[3])) + ((pb[0] + pb[1]) + (pb[2] + pb[3]))) * (1.0f / 512.f) + 1e-6f); rc[ai][m] = r;
                const f32x4 v0 = acc[ai][0][m][0] * r, v1 = acc[ai][0][m][1] * r;
                float s = ((v0[0] * v0[0] + v0[1] * v0[1]) + (v0[2] * v0[2] + v0[3] * v0[3])) + ((v1[0] * v1[0] + v1[1] * v1[1]) + (v1[2] * v1[2] + v1[3] * v1[3]));
                s += bperm_xor(s, 16, lane); s += bperm_xor(s, 32, lane);
                if (fq == 0) X[(ai * HALF + wr * 64 + m * 16 + fr) * 4 + wc] = s; } }
        const f32x4 g0 = *(const f32x4*)(gk + wc * 32 + 8 * fq), g1 = *(const f32x4*)(gk + wc * 32 + 8 * fq + 4);
        float sr[2][4]; f32x4 kq[2][4];
#pragma unroll
        for (int ai = 0; ai < 2; ++ai)
#pragma unroll
            for (int m = 0; m < 4; ++m) { const int rw = row0 + ai * HALF + m * 16; sr[ai][m] = ssr[rw]; kq[ai][m] = *(const f32x4*)(kr + (size_t)rw * 80 + 16 * wc + 4 * fq); }
        __builtin_amdgcn_sched_barrier(0);
        asm volatile("s_waitcnt lgkmcnt(0)" ::: "memory"); __builtin_amdgcn_s_barrier();
#pragma unroll
        for (int ai = 0; ai < 2; ++ai)
#pragma unroll
            for (int m = 0; m < 4; ++m) { const int rw = row0 + ai * HALF + m * 16; const float r = rc[ai][m];
                const f32x4 p = *(const PG8_LAS f32x4*)(X + (ai * HALF + wr * 64 + m * 16 + fr) * 4);
                const float rn = __builtin_amdgcn_rsqf((((p[0] + p[1]) + (p[2] + p[3])) + sr[ai][m]) * (1.0f / 192.f) + 1e-6f), rk = r * rn;
                { const f32x4 v0 = acc[ai][0][m][0] * rk * g0, v1 = acc[ai][0][m][1] * rk * g1;
                  u32x4 w; w.x = cvt_pk_bf16(v0[0], v0[1]); w.y = cvt_pk_bf16(v0[2], v0[3]); w.z = cvt_pk_bf16(v1[0], v1[1]); w.w = cvt_pk_bf16(v1[2], v1[3]);
                  *(u32x4*)(K + (size_t)rw * 3072 + u.pn * 192 + wc * 32 + 8 * fq) = w; }
                { const f32x4 v0 = acc[ai][1][m][0] * r, v1 = acc[ai][1][m][1] * r;
                  u32x4 w; w.x = cvt_pk_bf16(v0[0], v0[1]); w.y = cvt_pk_bf16(v0[2], v0[3]); w.z = cvt_pk_bf16(v1[0], v1[1]); w.w = cvt_pk_bf16(v1[2], v1[3]);
                  *(u32x4*)(V + (size_t)rw * 2048 + u.pn * 128 + wc * 32 + 8 * fq) = w; }
                { const f32x4 q = kq[ai][m] * rn;
                  u32x2 w; w.x = cvt_pk_bf16(q[0], q[1]); w.y = cvt_pk_bf16(q[2], q[3]);
                  *(u32x2*)(K + (size_t)rw * 3072 + u.pn * 192 + 128 + 16 * wc + 4 * fq) = w; } }
    }
};
template <int MODE> struct EpiMerge {
    static constexpr bool PERM = true, AFTER_DRAIN = false;
    const bf16_t* gate; bf16_t* Mb;
    __device__ __forceinline__ void operator()(const f32x4 (&acc)[2][2][4][2], const Unit& u, int wr, int wc, int fr, int fq) const {
        const int row0 = u.pm * BM + wr * 64 + fr, col0 = u.pn * BM + wc * 32 + 8 * fq;
#pragma unroll
        for (int ai = 0; ai < 2; ++ai) {
            u32x4 gw[4][2], mw[4][2];
#pragma unroll
            for (int m = 0; m < 4; ++m)
#pragma unroll
                for (int bj = 0; bj < 2; ++bj) { const size_t r = (size_t)(row0 + ai * HALF + m * 16); const int c = col0 + bj * HALF;
                    gw[m][bj] = *(const u32x4*)(gate + r * 6144 + c); if (MODE >= 1) mw[m][bj] = *(const u32x4*)(Mb + r * 2048 + c); }
            __builtin_amdgcn_sched_barrier(0);
#pragma unroll
            for (int m = 0; m < 4; ++m)
#pragma unroll
                for (int bj = 0; bj < 2; ++bj) { const size_t r = (size_t)(row0 + ai * HALF + m * 16); const int c = col0 + bj * HALF; const u32x4 g_ = gw[m][bj];
                    f32x4 g0, g1; g0[0] = sigmoidf_fast(__uint_as_float(g_.x << 16)); g0[1] = sigmoidf_fast(__uint_as_float(g_.x & 0xffff0000u)); g0[2] = sigmoidf_fast(__uint_as_float(g_.y << 16)); g0[3] = sigmoidf_fast(__uint_as_float(g_.y & 0xffff0000u));
                    g1[0] = sigmoidf_fast(__uint_as_float(g_.z << 16)); g1[1] = sigmoidf_fast(__uint_as_float(g_.z & 0xffff0000u)); g1[2] = sigmoidf_fast(__uint_as_float(g_.w << 16)); g1[3] = sigmoidf_fast(__uint_as_float(g_.w & 0xffff0000u));
                    f32x4 v0 = g0 * acc[ai][bj][m][0], v1 = g1 * acc[ai][bj][m][1];
                    if (MODE >= 1) { const u32x4 q = mw[m][bj];
                        v0[0] += __uint_as_float(q.x << 16); v0[1] += __uint_as_float(q.x & 0xffff0000u); v0[2] += __uint_as_float(q.y << 16); v0[3] += __uint_as_float(q.y & 0xffff0000u);
                        v1[0] += __uint_as_float(q.z << 16); v1[1] += __uint_as_float(q.z & 0xffff0000u); v1[2] += __uint_as_float(q.w << 16); v1[3] += __uint_as_float(q.w & 0xffff0000u); }
                    u32x4 w; w.x = cvt_pk_bf16(v0[0], v0[1]); w.y = cvt_pk_bf16(v0[2], v0[3]); w.z = cvt_pk_bf16(v1[0], v1[1]); w.w = cvt_pk_bf16(v1[2], v1[3]);
                    *(u32x4*)(Mb + r * 2048 + c) = w; }
            __builtin_amdgcn_sched_barrier(0); }
    }
};
template <bool SRCBF> struct EpiResidB {
    static constexpr bool PERM = true, AFTER_DRAIN = false;
    const void* xin; bf16_t* xout;
    __device__ __forceinline__ void operator()(const f32x4 (&acc)[2][2][4][2], const Unit& u, int wr, int wc, int fr, int fq) const {
        const int row0 = u.pm * BM + wr * 64 + fr, col0 = u.pn * BM + wc * 32 + 8 * fq;
#pragma unroll
        for (int ai = 0; ai < 2; ++ai) {
            u32x4 xw[4][2]; f32x4 xa[4][2][2];
#pragma unroll
            for (int m = 0; m < 4; ++m)
#pragma unroll
                for (int bj = 0; bj < 2; ++bj) { const size_t o = (size_t)(row0 + ai * HALF + m * 16) * 2048 + col0 + bj * HALF;
                    if (SRCBF) xw[m][bj] = __builtin_nontemporal_load((const u32x4*)((const bf16_t*)xin + o));
                    else { xa[m][bj][0] = __builtin_nontemporal_load((const f32x4*)((const float*)xin + o)); xa[m][bj][1] = __builtin_nontemporal_load((const f32x4*)((const float*)xin + o + 4)); } }
            __builtin_amdgcn_sched_barrier(0);
#pragma unroll
            for (int m = 0; m < 4; ++m)
#pragma unroll
                for (int bj = 0; bj < 2; ++bj) { const size_t o = (size_t)(row0 + ai * HALF + m * 16) * 2048 + col0 + bj * HALF;
                    f32x4 v0 = acc[ai][bj][m][0], v1 = acc[ai][bj][m][1];
                    if (SRCBF) { const u32x4 q = xw[m][bj];
                        v0[0] += __uint_as_float(q.x << 16); v0[1] += __uint_as_float(q.x & 0xffff0000u); v0[2] += __uint_as_float(q.y << 16); v0[3] += __uint_as_float(q.y & 0xffff0000u);
                        v1[0] += __uint_as_float(q.z << 16); v1[1] += __uint_as_float(q.z & 0xffff0000u); v1[2] += __uint_as_float(q.w << 16); v1[3] += __uint_as_float(q.w & 0xffff0000u); }
                    else { v0 += xa[m][bj][0]; v1 += xa[m][bj][1]; }
                    u32x4 w; w.x = cvt_pk_bf16(v0[0], v0[1]); w.y = cvt_pk_bf16(v0[2], v0[3]); w.z = cvt_pk_bf16(v1[0], v1[1]); w.w = cvt_pk_bf16(v1[2], v1[3]);
                    *(u32x4*)(xout + o) = w; }
            __builtin_amdgcn_sched_barrier(0); }
    }
};
struct EpiResid {
    static constexpr bool PERM = false, AFTER_DRAIN = false;
    const float* xin; float* xout;
    __device__ __forceinline__ void operator()(const f32x4 (&acc)[2][2][4][2], const Unit& u, int wr, int wc, int fr, int fq) const {
        const int row0 = u.pm * BM + wr * 64 + fr, col0 = u.pn * BM + wc * 32 + 4 * fq;
#pragma unroll
        for (int ai = 0; ai < 2; ++ai) {
            f32x4 xv[4][2][2];
#pragma unroll
            for (int m = 0; m < 4; ++m)
#pragma unroll
                for (int bj = 0; bj < 2; ++bj)
#pragma unroll
                    for (int n = 0; n < 2; ++n) xv[m][bj][n] = *(const f32x4*)(xin + (size_t)(row0 + ai * HALF + m * 16) * 2048 + col0 + bj * HALF + n * 16);
            __builtin_amdgcn_sched_barrier(0);
#pragma unroll
            for (int m = 0; m < 4; ++m)
#pragma unroll
                for (int bj = 0; bj < 2; ++bj)
#pragma unroll
                    for (int n = 0; n < 2; ++n) *(f32x4*)(xout + (size_t)(row0 + ai * HALF + m * 16) * 2048 + col0 + bj * HALF + n * 16) = xv[m][bj][n] + acc[ai][bj][m][n];
            __builtin_amdgcn_sched_barrier(0); }
    }
};
struct EpiSwiglu {
    static constexpr bool PERM = true, AFTER_DRAIN = false;
    bf16_t* act; const float* sr;
    __device__ __forceinline__ void operator()(const f32x4 (&acc)[2][2][4][2], const Unit& u, int wr, int wc, int fr, int fq) const {
        const int row0 = u.pm * BM + wr * 64 + fr, col0 = (u.pn & 3) * 128 + wc * 32 + 8 * fq;
        float rs[2][4];
#pragma unroll
        for (int ai = 0; ai < 2; ++ai)
#pragma unroll
            for (int m = 0; m < 4; ++m) rs[ai][m] = sr[row0 + ai * HALF + m * 16];
        __builtin_amdgcn_sched_barrier(0);
#pragma unroll
        for (int ai = 0; ai < 2; ++ai)
#pragma unroll
            for (int m = 0; m < 4; ++m) { bf16_t* rowp = act + (size_t)(row0 + ai * HALF + m * 16) * 512 + col0;
                float o[8];
#pragma unroll
                for (int n = 0; n < 2; ++n)
#pragma unroll
                    for (int i = 0; i < 4; ++i) { const float g = acc[ai][0][m][n][i] * rs[ai][m], up = acc[ai][1][m][n][i] * rs[ai][m]; o[4 * n + i] = g * sigmoidf_fast(g) * up; }
                u32x4 w; w.x = cvt_pk_bf16(o[0], o[1]); w.y = cvt_pk_bf16(o[2], o[3]); w.z = cvt_pk_bf16(o[4], o[5]); w.w = cvt_pk_bf16(o[6], o[7]);
                *(u32x4*)rowp = w; }
    }
};
struct EpiDown {
    static constexpr bool PERM = true, AFTER_DRAIN = false;
    bf16_t* Y; const float* sw;
    __device__ __forceinline__ void operator()(const f32x4 (&acc)[2][2][4][2], const Unit& u, int wr, int wc, int fr, int fq) const {
        const int row0 = u.pm * BM + wr * 64 + fr, col0 = (u.pn & 7) * 256 + wc * 32 + 8 * fq;
        float swv[2][4];
#pragma unroll
        for (int ai = 0; ai < 2; ++ai)
#pragma unroll
            for (int m = 0; m < 4; ++m) swv[ai][m] = sw[row0 + ai * HALF + m * 16];
        __builtin_amdgcn_sched_barrier(0);
#pragma unroll
        for (int ai = 0; ai < 2; ++ai)
#pragma unroll
            for (int m = 0; m < 4; ++m) { const int r = row0 + ai * HALF + m * 16; const float s = swv[ai][m]; bf16_t* rowp = Y + (size_t)r * 2048 + col0;
#pragma unroll
                for (int bj = 0; bj < 2; ++bj) { const f32x4 v0 = acc[ai][bj][m][0] * s, v1 = acc[ai][bj][m][1] * s;
                    u32x4 w; w.x = cvt_pk_bf16(v0[0], v0[1]); w.y = cvt_pk_bf16(v0[2], v0[3]); w.z = cvt_pk_bf16(v1[0], v1[1]); w.w = cvt_pk_bf16(v1[2], v1[3]);
                    *(u32x4*)(rowp + bj * HALF) = w; } }
    }
};
struct MoeOrder {
    const int* tab; int ncol, G, c;
    __device__ __forceinline__ bool next(int i, Unit& u) const {
        if (G & 7) { const int nrt = __builtin_amdgcn_readfirstlane(tab[256]); const int L = i * G + c; if (L >= nrt * ncol) return false;
            const int R = L / ncol, j = L - R * ncol; u.pm = R; u.pn = __builtin_amdgcn_readfirstlane(tab[R]) * ncol + j; return true; }
        const int x = c & 7, r = c >> 3, W = G >> 3; const int* xo = tab + 320 + 9 * x;
        const int L = i * W + r; if (L >= __builtin_amdgcn_readfirstlane(xo[8]) * ncol) return false;
        const int ut = L / ncol, j = L - ut * ncol; int k = 0, base = 0;
#pragma unroll
        for (int kk = 1; kk < 8; ++kk) { const int v = __builtin_amdgcn_readfirstlane(xo[kk]); if (ut >= v) { k = kk; base = v; } }
        const int e = x + 8 * k; u.pm = __builtin_amdgcn_readfirstlane(tab[400 + e]) + (ut - base); u.pn = e * ncol + j; return true;
    }
    __device__ __forceinline__ void a_ready(const Unit&) const {}
    __device__ __forceinline__ void done(const Unit&) const {}
};
template <class Epi, class Sched, bool ALIGN_EPI = false, bool SP2 = false>
__device__ __forceinline__ void gemm_phase(PG8_LAS unsigned char* lds, const Gemm g, const Sched& S, const Epi& E) {
    int tid_ = threadIdx.x; asm volatile("" : "+v"(tid_));
    const int tid = tid_, wid = __builtin_amdgcn_readfirstlane(tid >> 6), lane = tid & 63, wr = wid >> 2, wc = wid & 3, fr = lane & 15, fq = lane >> 4;
    const int K = g.K, nt = K / BK;
    unsigned voffA[2], voffB[2];
#pragma unroll
    for (int i = 0; i < 2; ++i) { int R, C; stage_rc(tid * 16 + i * 8192, R, C); const int Rb = Epi::PERM ? ((R & ~31) + perm32(R & 31)) : R;
        voffA[i] = (unsigned)(R * K + C) * 2u; voffB[i] = (unsigned)(Rb * K + C) * 2u; }
    const size_t kstep = (size_t)(BK * 2);
    const size_t hstep = (size_t)HALF * K * 2;
    const size_t tstep = 2 * hstep;
    const unsigned ldsw = (unsigned)wid * 1024u;
    const int aoff = lds_byte(wr * 64 + fr, fq * 8), boff = lds_byte(wc * 32 + fr, fq * 8);
#define PG8_SA(b, h) (((b) * 2 + (h)) * HTB)
#define PG8_SB(b, h) ((4 + (b) * 2 + (h)) * HTB)
#define PG8_STAGE(bufoff, gbase, voff) do { _Pragma("unroll") for (int _i = 0; _i < 2; ++_i) \
        __builtin_amdgcn_global_load_lds((const unsigned*)((const char*)(gbase) + (voff)[_i]), (PG8_LAS unsigned*)(lds + (bufoff) + ldsw + _i * 8192), 16, 0, 0); } while (0)
#define PG8_LDA(dst, b, h) do { _Pragma("unroll") for (int m = 0; m < 4; ++m) _Pragma("unroll") for (int k = 0; k < 2; ++k) dst[m][k] = *(const PG8_LAS bf16x8*)(lds + PG8_SA(b, h) + aoff + m * 2048 + k * 1024); } while (0)
#define PG8_LDB(dst, b, h) do { _Pragma("unroll") for (int n = 0; n < 2; ++n) _Pragma("unroll") for (int k = 0; k < 2; ++k) dst[n][k] = *(const PG8_LAS bf16x8*)(lds + PG8_SB(b, h) + boff + n * 2048 + k * 1024); } while (0)
#define PG8_MMA(ai, bj, At, Bt) do { __builtin_amdgcn_s_setprio(1); _Pragma("unroll") for (int m = 0; m < 4; ++m) _Pragma("unroll") for (int n = 0; n < 2; ++n) _Pragma("unroll") for (int k = 0; k < 2; ++k) \
        acc[ai][bj][m][n] = __builtin_amdgcn_mfma_f32_16x16x32_bf16(Bt[n][k], At[m][k], acc[ai][bj][m][n], 0, 0, 0); __builtin_amdgcn_s_setprio(0); } while (0)
#define PG8_WAIT_V(n) asm volatile("s_waitcnt vmcnt(" #n ")" ::: "memory")
#define PG8_WAIT_L(n) asm volatile("s_waitcnt lgkmcnt(" #n ")" ::: "memory")
#define PG8_BAR __builtin_amdgcn_s_barrier()
#define PG8_SCHED __builtin_amdgcn_sched_barrier(0)
    Unit cur, nxt; int ui = 0;
    if (!S.next(0, cur)) return;
    f32x4 acc[2][2][4][2];
#pragma unroll
    for (int a = 0; a < 2; ++a)
#pragma unroll
        for (int b = 0; b < 2; ++b)
#pragma unroll
            for (int m = 0; m < 4; ++m)
#pragma unroll
                for (int n = 0; n < 2; ++n) acc[a][b][m][n] = (f32x4){0.f, 0.f, 0.f, 0.f};
    bf16x8 At[4][2], B0[2][2], B1[2][2];
    const char* cA = (const char*)g.A + (size_t)cur.pm * tstep; const char* cB = (const char*)g.Bt + (size_t)cur.pn * tstep;
    S.a_ready(cur);
    if constexpr (SP2) {
        PG8_STAGE(PG8_SB(0, 0), cB, voffB); PG8_STAGE(PG8_SB(0, 1), cB + hstep, voffB); PG8_STAGE(PG8_SA(0, 0), cA, voffA); PG8_STAGE(PG8_SA(0, 1), cA + hstep, voffA);
        if (wr == 1) PG8_BAR;
        PG8_WAIT_V(2); PG8_BAR;
        PG8_STAGE(PG8_SB(1, 0), cB + kstep, voffB); PG8_STAGE(PG8_SA(1, 0), cA + kstep, voffA); PG8_STAGE(PG8_SB(1, 1), cB + hstep + kstep, voffB);
        PG8_WAIT_V(6); PG8_BAR;
    } else {
        PG8_STAGE(PG8_SB(0, 0), cB, voffB); PG8_STAGE(PG8_SA(0, 0), cA, voffA); PG8_STAGE(PG8_SB(0, 1), cB + hstep, voffB); PG8_STAGE(PG8_SA(0, 1), cA + hstep, voffA);
        if (wr == 1) PG8_BAR;
        PG8_WAIT_V(4); PG8_BAR;
        PG8_STAGE(PG8_SB(1, 0), cB + kstep, voffB); PG8_STAGE(PG8_SA(1, 0), cA + kstep, voffA); PG8_STAGE(PG8_SB(1, 1), cB + hstep + kstep, voffB);
        PG8_WAIT_V(6); PG8_BAR;
    }
    for (;;) {
        const bool has_next = S.next(ui + 1, nxt);
        const char* nA = has_next ? (const char*)g.A + (size_t)nxt.pm * tstep : cA; const char* nB = has_next ? (const char*)g.Bt + (size_t)nxt.pn * tstep : cB;
        for (int t = 0; t < nt; t += 2) {
            const bool last = (t == nt - 2);
            const char* a1 = cA + (size_t)(t + 1) * kstep;
            const char* a2 = last ? nA : cA + (size_t)(t + 2) * kstep; const char* b2 = last ? nB : cB + (size_t)(t + 2) * kstep;
            const char* a3 = a2 + kstep; const char* b3 = b2 + kstep;
            if (last && has_next) S.a_ready(nxt);
            if constexpr (SP2) {
            PG8_LDB(B0, 0, 0); PG8_LDB(B1, 0, 1); PG8_SCHED; PG8_LDA(At, 0, 0); PG8_STAGE(PG8_SA(1, 1), a1 + hstep, voffA);
            PG8_WAIT_V(8); PG8_WAIT_L(0); PG8_BAR; PG8_MMA(0, 0, At, B0); PG8_MMA(0, 1, At, B1); PG8_BAR; PG8_SCHED;
            PG8_LDA(At, 0, 1); PG8_STAGE(PG8_SB(0, 0), b2, voffB); PG8_STAGE(PG8_SB(0, 1), b2 + hstep, voffB); PG8_STAGE(PG8_SA(0, 0), a2, voffA);
            PG8_WAIT_V(8); PG8_WAIT_L(0); PG8_BAR; PG8_MMA(1, 0, At, B0); PG8_MMA(1, 1, At, B1); PG8_BAR; PG8_SCHED;
            PG8_LDB(B0, 1, 0); PG8_LDB(B1, 1, 1); PG8_SCHED; PG8_LDA(At, 1, 0); PG8_STAGE(PG8_SA(0, 1), a2 + hstep, voffA);
            PG8_WAIT_V(8); PG8_WAIT_L(0); PG8_BAR; PG8_MMA(0, 0, At, B0); PG8_MMA(0, 1, At, B1); PG8_BAR; PG8_SCHED;
            PG8_LDA(At, 1, 1); PG8_STAGE(PG8_SB(1, 0), b3, voffB); PG8_STAGE(PG8_SB(1, 1), b3 + hstep, voffB); PG8_STAGE(PG8_SA(1, 0), a3, voffA);
            PG8_WAIT_V(8); PG8_WAIT_L(0); PG8_BAR; PG8_MMA(1, 0, At, B0); PG8_MMA(1, 1, At, B1); PG8_BAR; PG8_SCHED;
            } else {
            PG8_LDB(B0, 0, 0); PG8_SCHED; PG8_LDA(At, 0, 0); PG8_STAGE(PG8_SA(1, 1), a1 + hstep, voffA);
            PG8_WAIT_L(8); PG8_BAR; PG8_WAIT_L(0); PG8_MMA(0, 0, At, B0); PG8_BAR; PG8_SCHED;
            PG8_LDB(B1, 0, 1); PG8_STAGE(PG8_SB(0, 0), b2, voffB);
            PG8_BAR; PG8_WAIT_L(0); PG8_MMA(0, 1, At, B1); PG8_BAR;
            PG8_LDA(At, 0, 1); PG8_STAGE(PG8_SA(0, 0), a2, voffA);
            PG8_BAR; PG8_WAIT_L(0); PG8_MMA(1, 0, At, B0); PG8_BAR; PG8_SCHED;
            PG8_STAGE(PG8_SB(0, 1), b2 + hstep, voffB);
            PG8_WAIT_V(6); PG8_BAR; PG8_MMA(1, 1, At, B1); PG8_BAR;
            PG8_LDB(B0, 1, 0); PG8_SCHED; PG8_LDA(At, 1, 0); PG8_STAGE(PG8_SA(0, 1), a2 + hstep, voffA);
            PG8_WAIT_L(8); PG8_BAR; PG8_WAIT_L(0); PG8_MMA(0, 0, At, B0); PG8_BAR; PG8_SCHED;
            PG8_LDB(B1, 1, 1); PG8_STAGE(PG8_SB(1, 0), b3, voffB);
            PG8_BAR; PG8_WAIT_L(0); PG8_MMA(0, 1, At, B1); PG8_BAR;
            PG8_LDA(At, 1, 1); PG8_STAGE(PG8_SA(1, 0), a3, voffA);
            PG8_BAR; PG8_WAIT_L(0); PG8_MMA(1, 0, At, B0); PG8_BAR; PG8_SCHED;
            PG8_STAGE(PG8_SB(1, 1), b3 + hstep, voffB);
            PG8_WAIT_V(6); PG8_BAR; PG8_MMA(1, 1, At, B1); PG8_BAR;
            }
        }
        if constexpr (ALIGN_EPI) { if (wr == 0) PG8_BAR; }
        if constexpr (!Epi::AFTER_DRAIN) { E(acc, cur, wr, wc, fr, fq); S.done(cur); }
        if (!has_next) break;
#pragma unroll
        for (int a = 0; a < 2; ++a)
#pragma unroll
            for (int b = 0; b < 2; ++b)
#pragma unroll
                for (int m = 0; m < 4; ++m)
#pragma unroll
                    for (int n = 0; n < 2; ++n) acc[a][b][m][n] = (f32x4){0.f, 0.f, 0.f, 0.f};
        cur = nxt; cA = nA; cB = nB; ++ui;
        if constexpr (ALIGN_EPI) { if (wr == 1) PG8_BAR; }
    }
    PG8_WAIT_V(0);
    if constexpr (!ALIGN_EPI) { if (wr == 0) PG8_BAR; }
    PG8_BAR;
    if constexpr (Epi::AFTER_DRAIN) { E.fused(acc, cur, wr, wc, fr, fq, lds, wid, lane); S.done(cur); }
#undef PG8_SA
#undef PG8_SB
#undef PG8_STAGE
#undef PG8_LDA
#undef PG8_LDB
#undef PG8_MMA
#undef PG8_WAIT_V
#undef PG8_WAIT_L
#undef PG8_BAR
#undef PG8_SCHED
}
}
constexpr int NWAVES = 8;
constexpr int NTOK = 16384, DM = 2048, SEQ = 4096, NBATCH = 4, NH = 16, DEPTH = 2;
constexpr int DIN = 13392, NBIG = 13312;
constexpr int NEXP = 64, DEXP = 512, NASG = 2 * NTOK, MAXSLOT = 49152;
constexpr float EPS = 1e-6f, LOG2E = 1.4426950408889634f;

constexpr size_t MiB = 1u << 20;
constexpr size_t WS_CTL = 0, CTL_ZERO_BYTES = 1 * MiB;
constexpr size_t WS_TAB = 1 * MiB;
constexpr size_t WS_GN = 1 * MiB + 4096;
constexpr size_t WS_PART = 1 * MiB + 65536;
constexpr size_t WS_RS = 1 * MiB + 655360, WS_RS2 = 1 * MiB + 720896;
constexpr size_t WS_WIN = 2 * MiB, WS_WSK = 54 * MiB, WS_WUQ = 55 * MiB, WS_WUKV = 58 * MiB, WS_WBA = 62 * MiB, WS_WBB = 70 * MiB, WS_WBC = 74 * MiB,
                 WS_WOUT = 78 * MiB, WS_WRT = 86 * MiB, WS_WGU = 88 * MiB, WS_WD = 344 * MiB;
constexpr size_t WS_XN = 472 * MiB;
constexpr size_t WS_CQ = 536 * MiB, WS_CKV = 552 * MiB;
constexpr size_t WS_QKV6 = 568 * MiB;
constexpr size_t WS_GATES = 760 * MiB;
constexpr size_t WS_SK = 952 * MiB;
constexpr size_t WS_ROPE = 958 * MiB;
constexpr size_t WS_CUMF = 962 * MiB;
constexpr size_t WS_QM = 964 * MiB, WS_KM = 1060 * MiB;
constexpr size_t WS_VM = 1156 * MiB, WS_KNOPE = 1220 * MiB;
constexpr size_t WS_OA = 1284 * MiB, WS_OB = 1348 * MiB, WS_OC = 1380 * MiB;
constexpr size_t WS_MF = 1412 * MiB, WS_MB = 1540 * MiB;
constexpr size_t WS_HS = WS_QKV6;
constexpr size_t WS_ACT = WS_GATES;
constexpr size_t WS_Y = WS_QM;
constexpr size_t WS_ASG = 1604 * MiB;
constexpr size_t WS_XB = 1606 * MiB;
constexpr size_t WS_END = 1734 * MiB;
constexpr int CW_BAR = 4096;
constexpr int CW_AQ = 12288;
constexpr int CW_CNT = 8192;

constexpr int RING_OFF = 0, RING_BYTES = 139264;
constexpr int LDSCTL_OFF = RING_BYTES, MISC_OFF = LDSCTL_OFF + 320;
constexpr int LDS_BYTES = 147456;

#define GAS __attribute__((address_space(1)))
#define LAS __attribute__((address_space(3)))
typedef unsigned short bf16;
typedef unsigned v4u __attribute__((ext_vector_type(4)));
typedef unsigned v2u __attribute__((ext_vector_type(2)));
typedef float f32x4 __attribute__((ext_vector_type(4)));
typedef float f32x16 __attribute__((ext_vector_type(16)));
typedef short bf16x8 __attribute__((ext_vector_type(8)));
typedef short s16x4 __attribute__((ext_vector_type(4)));
typedef GAS unsigned gu32;
#define LDS_WAIT() asm volatile("s_waitcnt lgkmcnt(0)" ::: "memory")
#define VM_WAIT() asm volatile("s_waitcnt vmcnt(0)" ::: "memory")
__device__ __forceinline__ unsigned f2bf(float f) { unsigned u = __builtin_bit_cast(unsigned, f); return (u + 0x7fffu + ((u >> 16) & 1u)) >> 16; }
__device__ __forceinline__ unsigned pk2(float lo, float hi) { unsigned r; asm("v_cvt_pk_bf16_f32 %0, %1, %2" : "=v"(r) : "v"(lo), "v"(hi)); return r; }
__device__ __forceinline__ void glds16(const void* gsrc, unsigned lds_dst) { unsigned keep;
    asm volatile("s_mov_b32 %0, m0\n\ts_mov_b32 m0, %2\n\ts_nop 0\n\tglobal_load_lds_dwordx4 %1, off\n\ts_mov_b32 m0, %0" : "=&s"(keep) : "v"(gsrc), "s"(lds_dst) : "memory"); }
__device__ __forceinline__ void glds4(const void* gsrc, unsigned lds_dst) { unsigned keep;
    asm volatile("s_mov_b32 %0, m0\n\ts_mov_b32 m0, %2\n\ts_nop 0\n\tglobal_load_lds_dword %1, off\n\ts_mov_b32 m0, %0" : "=&s"(keep) : "v"(gsrc), "s"(lds_dst) : "memory"); }
__device__ __forceinline__ float bflo(unsigned w) { return __uint_as_float(w << 16); }
__device__ __forceinline__ float bfhi(unsigned w) { return __uint_as_float(w & 0xffff0000u); }
using pg8::bperm_xor;
__device__ __forceinline__ float bperm_up(float v, int d, int lane) { return __int_as_float(__builtin_amdgcn_ds_bpermute((lane - d) << 2, __float_as_int(v))); }
__device__ __forceinline__ float wave_sum(float v, int lane) {
#pragma unroll
    for (int o = 1; o < 64; o <<= 1) v += bperm_xor(v, o, lane);
    return v;
}
static_assert(pg8::EpiSeg::O_CQ == WS_CQ && pg8::EpiSeg::O_CKV == WS_CKV && pg8::EpiSeg::O_QKV6 == WS_QKV6 && pg8::EpiSeg::O_GATES == WS_GATES && pg8::EpiSeg::O_PART == WS_PART && pg8::EpiSeg::O_RS == WS_RS, "EpiSeg offsets vs workspace map");
#define XB_TMO      128
#define XB_XCNT(j)  (256  + 64 * (j))
#define XB_XSUB(j)  (1280 + 64 * (j))
#define XB_XGEN(j)  (2304 + 64 * (j))
#define XB_TOP      3328
#define XB_TOPGEN   3392
#define XCD_BAR_WORDS 3456
#define XB_SPIN_CAP (1u << 18)

__device__ __forceinline__ unsigned xb_ld(unsigned* p)              { return __hip_atomic_load(p, __ATOMIC_RELAXED, __HIP_MEMORY_SCOPE_AGENT); }
__device__ __forceinline__ unsigned xb_add(unsigned* p, unsigned v) { return __hip_atomic_fetch_add(p, v, __ATOMIC_RELAXED, __HIP_MEMORY_SCOPE_AGENT); }
__device__ __forceinline__ unsigned xb_xcc_id() { return (unsigned)__builtin_amdgcn_s_getreg((3 << 11) | 20) & 0xFu; }
#define XB_SPIN(cond, bar) do { unsigned _sp = 0; while (cond) { __builtin_amdgcn_s_sleep(1); \
    if ((++_sp & 255u) == 0u) { if (xb_ld(&(bar)[XB_TMO])) break; if (_sp > XB_SPIN_CAP) { atomicAdd(&(bar)[XB_TMO], 1u); break; } } } } while (0)

struct XcdBarrier {
    unsigned* bar; unsigned x;
    volatile LAS unsigned* st;
};

__device__ __forceinline__ XcdBarrier xcd_barrier_post(unsigned* bar, volatile LAS unsigned* st) {
    XcdBarrier b; b.bar = bar; b.x = xb_xcc_id(); b.st = st;
    if (threadIdx.x == 0) (void)xb_add(&bar[XB_XCNT(b.x)], 1u);
    return b;
}
__device__ __forceinline__ void xcd_barrier_complete(unsigned* bar, unsigned x, unsigned& nloc, unsigned& nx) {
    const unsigned G = gridDim.x * gridDim.y * gridDim.z;
    unsigned sum, cnt, mine, sp = 0u;
    for (;;) {
        sum = 0u; cnt = 0u; mine = 0u;
#pragma unroll
        for (unsigned j = 0; j < 16; ++j) { const unsigned c = xb_ld(&bar[XB_XCNT(j)]); sum += c; cnt += (c > 0u) ? 1u : 0u; mine = (j == x) ? c : mine; }
        if (sum == G) break;
        __builtin_amdgcn_s_sleep(1);
        if ((++sp & 255u) == 0u) { if (xb_ld(&bar[XB_TMO])) break; if (sp > XB_SPIN_CAP) { atomicAdd(&bar[XB_TMO], 1u); break; } }
    }
    nloc = mine > 0u ? mine : 1u; nx = cnt > 0u ? cnt : 1u;
}

__device__ __forceinline__ void xcd_barrier(const XcdBarrier& b) {
    asm volatile("s_waitcnt vmcnt(0)" ::: "memory");
    __syncthreads();
    if (threadIdx.x == 0) {
        unsigned* bar = b.bar;
        __builtin_amdgcn_s_waitcnt(0);
        unsigned nloc = b.st[0], nx = b.st[1];
        if (nloc == 0u) { xcd_barrier_complete(bar, b.x, nloc, nx); b.st[0] = nloc; b.st[1] = nx; }
        const unsigned old = xb_add(&bar[XB_XSUB(b.x)], 1u);
        const unsigned gen = old / nloc;
        if (old + 1u == (gen + 1u) * nloc) {
            __builtin_amdgcn_fence(__ATOMIC_RELEASE, "agent");
            asm volatile("s_waitcnt vmcnt(0)" ::: "memory");
            const unsigned og = xb_add(&bar[XB_TOP], 1u);
            const unsigned tg = og / nx;
            if (og + 1u == (tg + 1u) * nx) xb_add(&bar[XB_TOPGEN], 1u);
            else XB_SPIN(xb_ld(&bar[XB_TOPGEN]) == tg, bar);
            __builtin_amdgcn_fence(__ATOMIC_ACQUIRE, "agent");
            xb_add(&bar[XB_XGEN(b.x)], 1u);
            asm volatile("s_waitcnt vmcnt(0)" ::: "memory");
        } else {
            XB_SPIN(xb_ld(&bar[XB_XGEN(b.x)]) == gen, bar);
            __builtin_amdgcn_fence(__ATOMIC_ACQUIRE, "agent");
            asm volatile("s_waitcnt vmcnt(0)" ::: "memory");
        }
    }
    __syncthreads();
}

template <int PMODE = 0> __device__ __forceinline__ void conv_item64(const float* __restrict__ src, int ld, int K, int scol0, bf16* dst, int drow0, int nvalid, int kb, int lane, LAS unsigned char* tile, const float* kgain = nullptr, bool split = false) {
    const int g = lane >> 4, c = lane & 15, k0 = 64 * kb + 16 * g; const bool ok = 4 * c < nvalid;
    f32x4 v[16]; const float* p = src + (size_t)k0 * ld + scol0 + 4 * c;
#pragma unroll
    for (int i = 0; i < 16; ++i) v[i] = (ok && PMODE != 2) ? __builtin_nontemporal_load((const GAS f32x4*)(p + (size_t)i * ld)) : (f32x4){0.f, 0.f, 0.f, 0.f};
    if (kgain) {
#pragma unroll
        for (int i4 = 0; i4 < 4; ++i4) { const f32x4 kg = *(const GAS f32x4*)(kgain + k0 + 4 * i4); v[4 * i4] *= kg[0]; v[4 * i4 + 1] *= kg[1]; v[4 * i4 + 2] *= kg[2]; v[4 * i4 + 3] *= kg[3]; } }
#pragma unroll
    for (int j = 0; j < 4; ++j) { v4u o0, o1;
        o0.x = pk2(v[0][j], v[1][j]); o0.y = pk2(v[2][j], v[3][j]); o0.z = pk2(v[4][j], v[5][j]); o0.w = pk2(v[6][j], v[7][j]);
        o1.x = pk2(v[8][j], v[9][j]); o1.y = pk2(v[10][j], v[11][j]); o1.z = pk2(v[12][j], v[13][j]); o1.w = pk2(v[14][j], v[15][j]);
        LAS unsigned char* tp = tile + (4 * c + j) * 144 + 32 * g; *(LAS v4u*)tp = o0; *(LAS v4u*)(tp + 16) = o1; }
    LDS_WAIT(); asm volatile("" ::: "memory");
#pragma unroll
    for (int s = 0; s < 8; ++s) { const int row = (lane >> 3) + 8 * s, ch = lane & 7; const v4u w = *(const LAS v4u*)(tile + row * 144 + 16 * ch);
        const int drow = drow0 + row + ((split && row >= 32) ? 96 : 0);
        if (row < nvalid) { bf16* dp = dst + (size_t)drow * K + 64 * kb + 8 * ch;
            if (PMODE == 3) asm volatile("global_store_dwordx4 %0, %1, off sc0 sc1" :: "v"(dp), "v"(w) : "memory");
            else *(GAS v4u*)dp = w; } }
    LDS_WAIT(); asm volatile("" ::: "memory");
}
struct ConvSrc { const float *w_in, *w_uq, *w_ukv, *w_ba, *w_bb, *w_bc, *w_out, *g_cq, *g_ckv, *w_eg, *w_eu, *w_ed; };
template <int PMODE = 0> __device__ __forceinline__ void phase_convert(const ConvSrc& S, unsigned char* ws, int it_begin, int it_stride, int it_end, int lane, LAS unsigned char* tile) {
    bf16* WIN = (bf16*)(ws + WS_WIN); bf16* WUQ = (bf16*)(ws + WS_WUQ); bf16* WUKV = (bf16*)(ws + WS_WUKV);
    bf16* WBA = (bf16*)(ws + WS_WBA); bf16* WBB = (bf16*)(ws + WS_WBB); bf16* WBC = (bf16*)(ws + WS_WBC); bf16* WOUT = (bf16*)(ws + WS_WOUT);
    bf16* WGU = (bf16*)(ws + WS_WGU); bf16* WD = (bf16*)(ws + WS_WD);
    constexpr int I_IN0 = 16 * 32, I_IN1 = 96 * 32, I_IN2 = 96 * 32, I_SK0 = 1 * 32, I_SK1 = 1 * 32, I_UQ = 48 * 8, I_UKV = 64 * 8,
                  I_BA = 32 * 32, I_BB = 32 * 16, I_BC = 32 * 16, I_OUT = 32 * 32, I_GU = 16 * 32, I_D = 32 * 8, I_EXP = I_GU + I_D;
    constexpr int I_DENSE = I_IN0 + I_IN1 + I_IN2 + I_UQ + I_UKV + I_BA + I_BB + I_BC + I_OUT;
    constexpr int NITEMS = I_DENSE + NEXP * I_EXP;
    for (int it = it_begin; it < it_end; it += it_stride) {
        int r = it; const float* src; int ld, K, scol0, drow0, nvalid = 64, kb, nblk = 1; bf16* dst; const float* kg = nullptr; bool split = false; int jobid = 0;
        if (r >= I_DENSE) { r -= I_DENSE; const int e = r / I_EXP; r -= e * I_EXP;
            if (r < I_GU) { const int b = r & 15; kb = r >> 4; const int j = b >> 2, t = b & 3; ld = 512; K = 2048; dst = WGU + (size_t)e * 1024 * 2048; drow0 = 64 * b;
                if (t < 2) { src = S.w_eg + (size_t)e * 2048 * 512; scol0 = 128 * j + 64 * t; } else { src = S.w_eu + (size_t)e * 2048 * 512; scol0 = 128 * j + 64 * (t - 2); } }
            else { r -= I_GU; const int b = r & 31; kb = r >> 5; ld = 2048; K = 512; src = S.w_ed + (size_t)e * 512 * 2048; scol0 = 64 * b; dst = WD + (size_t)e * 2048 * 512; drow0 = 64 * b; }
        } else {
            if (r < I_IN0) { src = S.w_in; ld = DIN; K = 2048; nblk = 16; scol0 = 0; dst = WIN; drow0 = 0; }
            else if ((r -= I_IN0) < I_IN1) { src = S.w_in; ld = DIN; K = 2048; nblk = 96; scol0 = 1088; dst = WIN; drow0 = 1024; jobid = 1; }
            else if ((r -= I_IN1) < I_IN2) { src = S.w_in; ld = DIN; K = 2048; nblk = 96; scol0 = 7248; dst = WIN; drow0 = 7168; }
            else if ((r -= I_IN2) < I_UQ) { src = S.w_uq; ld = 3072; K = 512; nblk = 48; scol0 = 0; dst = WUQ; drow0 = 0; kg = S.g_cq; }
            else if ((r -= I_UQ) < I_UKV) { src = S.w_ukv; ld = 4096; K = 512; nblk = 64; scol0 = 0; dst = WUKV; drow0 = 0; kg = S.g_ckv; }
            else if ((r -= I_UKV) < I_BA) { src = S.w_ba; ld = 2048; K = 2048; nblk = 32; scol0 = 0; dst = WBA; drow0 = 0; }
            else if ((r -= I_BA) < I_BB) { src = S.w_bb; ld = 2048; K = 1024; nblk = 32; scol0 = 0; dst = WBB; drow0 = 0; }
            else if ((r -= I_BB) < I_BC) { src = S.w_bc; ld = 2048; K = 1024; nblk = 32; scol0 = 0; dst = WBC; drow0 = 0; }
            else { r -= I_BC; src = S.w_out; ld = 2048; K = 2048; nblk = 32; scol0 = 0; dst = WOUT; drow0 = 0; }
            const int b = r % nblk; kb = r / nblk; scol0 += 64 * b; drow0 += 64 * b;
            if (jobid == 1) { const int seg = b >> 4;
                if (seg != 2 && seg != 5) { split = true; drow0 = 1024 + 256 * (b >> 2) + 32 * (b & 3); } }
        }
        conv_item64<PMODE>(src, ld, K, scol0, dst, drow0, nvalid, kb, lane, tile, kg, split);
    }
}
constexpr int CONV_EXP_ITEMS = NEXP * (16 * 32 + 32 * 8);
struct ConvItem { const float* src; bf16* dst; int ld, K, scol0, drow0, kb; };
__device__ __forceinline__ ConvItem conv_expert_decode(const float* w_eg, const float* w_eu, const float* w_ed, bf16* WGU, bf16* WD, int it) {
    ConvItem I; const int e = it / 768; int r = it - e * 768;
    if (r < 512) { const int b = r & 15; I.kb = r >> 4; const int j = b >> 2, t = b & 3; I.ld = 512; I.K = 2048; I.dst = WGU + (size_t)e * 1024 * 2048; I.drow0 = 64 * b;
        if (t < 2) { I.src = w_eg + (size_t)e * 2048 * 512; I.scol0 = 128 * j + 64 * t; } else { I.src = w_eu + (size_t)e * 2048 * 512; I.scol0 = 128 * j + 64 * (t - 2); } }
    else { r -= 512; const int b = r & 31; I.kb = r >> 5; I.ld = 2048; I.K = 512; I.src = w_ed + (size_t)e * 512 * 2048; I.scol0 = 64 * b; I.dst = WD + (size_t)e * 2048 * 512; I.drow0 = 64 * b; }
    return I;
}
__device__ __forceinline__ void conv_load64(const ConvItem& I, int lane, f32x4 (&v)[16]) {
    const int g = lane >> 4, c = lane & 15, k0 = 64 * I.kb + 16 * g; const float* p = I.src + (size_t)k0 * I.ld + I.scol0 + 4 * c;
#pragma unroll
    for (int i = 0; i < 16; ++i) v[i] = __builtin_nontemporal_load((const GAS f32x4*)(p + (size_t)i * I.ld));
}
__device__ __forceinline__ void conv_store64(const ConvItem& I, int lane, LAS unsigned char* tile, const f32x4 (&v)[16]) {
    const int g = lane >> 4, c = lane & 15;
#pragma unroll
    for (int j = 0; j < 4; ++j) { v4u o0, o1;
        o0.x = pk2(v[0][j], v[1][j]); o0.y = pk2(v[2][j], v[3][j]); o0.z = pk2(v[4][j], v[5][j]); o0.w = pk2(v[6][j], v[7][j]);
        o1.x = pk2(v[8][j], v[9][j]); o1.y = pk2(v[10][j], v[11][j]); o1.z = pk2(v[12][j], v[13][j]); o1.w = pk2(v[14][j], v[15][j]);
        LAS unsigned char* tp = tile + (4 * c + j) * 144 + 32 * g; *(LAS v4u*)tp = o0; *(LAS v4u*)(tp + 16) = o1; }
    LDS_WAIT(); asm volatile("" ::: "memory");
#pragma unroll
    for (int s = 0; s < 8; ++s) { const int row = (lane >> 3) + 8 * s, ch = lane & 7; const v4u w = *(const LAS v4u*)(tile + row * 144 + 16 * ch);
        __builtin_nontemporal_store(w, (GAS v4u*)(I.dst + (size_t)(I.drow0 + row) * I.K + 64 * I.kb + 8 * ch)); }
    LDS_WAIT(); asm volatile("" ::: "memory");
}
__device__ __forceinline__ ConvItem conv_late_dense_decode(const float* w_ba, const float* w_bb, const float* w_bc, const float* w_out, unsigned char* ws, int d) {
    ConvItem I; I.ld = 2048; int r = d;
    if (r < 1024) { I.src = w_ba; I.dst = (bf16*)(ws + WS_WBA); I.K = 2048; }
    else if ((r -= 1024) < 512) { I.src = w_bb; I.dst = (bf16*)(ws + WS_WBB); I.K = 1024; }
    else if ((r -= 512) < 512) { I.src = w_bc; I.dst = (bf16*)(ws + WS_WBC); I.K = 1024; }
    else { r -= 512; I.src = w_out; I.dst = (bf16*)(ws + WS_WOUT); I.K = 2048; }
    const int b = r & 31; I.kb = r >> 5; I.scol0 = 64 * b; I.drow0 = 64 * b; return I;
}
__device__ __forceinline__ void conv_expert_items(const float* w_eg, const float* w_eu, const float* w_ed, const float* w_ba, const float* w_bb, const float* w_bc, const float* w_out, unsigned char* ws, int first, int dense_item, LAS unsigned char* tile) {
    int t_ = threadIdx.x; asm volatile("" : "+v"(t_)); const int lane = t_ & 63;
    bf16* WGU = (bf16*)(ws + WS_WGU); bf16* WD = (bf16*)(ws + WS_WD);
    f32x4 va[16], vb[16];
    ConvItem Ia = conv_expert_decode(w_eg, w_eu, w_ed, WGU, WD, first), Ib;
    conv_load64(Ia, lane, va);
#pragma unroll 1
    for (int j = 0; j < 16; j += 2) {
        Ib = conv_expert_decode(w_eg, w_eu, w_ed, WGU, WD, first + (j + 1) * 8);
        conv_load64(Ib, lane, vb); __builtin_amdgcn_sched_barrier(0);
        conv_store64(Ia, lane, tile, va); __builtin_amdgcn_sched_barrier(0);
        Ia = (j + 2 < 16) ? conv_expert_decode(w_eg, w_eu, w_ed, WGU, WD, first + (j + 2) * 8) : conv_late_dense_decode(w_ba, w_bb, w_bc, w_out, ws, dense_item);
        conv_load64(Ia, lane, va); __builtin_amdgcn_sched_barrier(0);
        conv_store64(Ib, lane, tile, vb); __builtin_amdgcn_sched_barrier(0);
    }
    conv_store64(Ia, lane, tile, va);
}
__device__ __forceinline__ void phase_convert_small(const float* w_in_l, const float* w_group_l, const float* w_router_l, bf16* WSK, bf16* WRT, int tid_g, int nthr_g) {
    for (int i = tid_g; i < 2 * 80 * 256; i += nthr_g) { const int which = i / (80 * 256), r = i - which * (80 * 256), n = r >> 8, k8 = r & 255; float v[8];
        if (which == 0) { const float* s = w_in_l + (size_t)(8 * k8) * DIN + (n < 64 ? 1024 + n : 7232 + (n - 64));
#pragma unroll
            for (int j = 0; j < 8; ++j) v[j] = s[(size_t)j * DIN]; }
        else {
#pragma unroll
            for (int j = 0; j < 8; ++j) { const int k = 8 * k8 + j; v[j] = n < 8 ? w_group_l[k * 8 + n] : (n < 72 ? w_router_l[k * 64 + (n - 8)] : 0.f); } }
        v4u o; o.x = pk2(v[0], v[1]); o.y = pk2(v[2], v[3]); o.z = pk2(v[4], v[5]); o.w = pk2(v[6], v[7]);
        const size_t idx = ((size_t)(((k8 >> 2) * 5 + (n >> 4)) * 64 + (k8 & 3) * 16 + (n & 15))) * 8;
        *(GAS v4u*)((which == 0 ? WSK : WRT) + idx) = o; }
}

__device__ __forceinline__ void phase_rmsnorm(const float* x, const float* gain, bf16* out, int gw, int NGW, int lane) {
    f32x4 g[8];
#pragma unroll
    for (int j = 0; j < 8; ++j) g[j] = ((const GAS f32x4*)gain)[lane + 64 * j];
    for (int row = gw; row < NTOK; row += NGW) {
        const GAS f32x4* xr = (const GAS f32x4*)(x + (size_t)row * DM) + lane; f32x4 v[8]; float s = 0.f;
#pragma unroll
        for (int j = 0; j < 8; ++j) { v[j] = xr[64 * j]; s += (v[j].x * v[j].x + v[j].y * v[j].y) + (v[j].z * v[j].z + v[j].w * v[j].w); }
        const float r = 1.0f / sqrtf(wave_sum(s, lane) * (1.0f / DM) + EPS);
        GAS v2u* o = (GAS v2u*)(out + (size_t)row * DM) + lane;
#pragma unroll
        for (int j = 0; j < 8; ++j) { v2u w; w.x = pk2(v[j].x * r * g[j].x, v[j].y * r * g[j].y); w.y = pk2(v[j].z * r * g[j].z, v[j].w * r * g[j].w); o[64 * j] = w; }
    }
}

__device__ __forceinline__ void skinny16x80(const bf16* A, const bf16* Wt, int row0, int lane, f32x4 (&acc)[5]) {
#pragma unroll
    for (int t = 0; t < 5; ++t) acc[t] = (f32x4){0.f, 0.f, 0.f, 0.f};
    const bf16* ap = A + (size_t)(row0 + (lane & 15)) * 2048 + 8 * (lane >> 4);
    const bf16* bp = Wt + (size_t)(lane & 15) * 2048 + 8 * (lane >> 4);
#pragma unroll 4
    for (int k0 = 0; k0 < 2048; k0 += 32) {
        const bf16x8 a = *(const GAS bf16x8*)(ap + k0);
#pragma unroll
        for (int t = 0; t < 5; ++t) { const bf16x8 b = *(const GAS bf16x8*)(bp + (size_t)t * 16 * 2048 + k0); acc[t] = __builtin_amdgcn_mfma_f32_16x16x32_bf16(a, b, acc[t], 0, 0, 0); }
    }
}
__device__ __forceinline__ void phase_skinny_store(const bf16* A, const bf16* Wt, float* out, int gw, int NGW, int lane) {
    for (int rg = gw; rg < NTOK / 16; rg += NGW) { f32x4 acc[5]; skinny16x80(A, Wt, rg * 16, lane, acc);
#pragma unroll
        for (int t = 0; t < 5; ++t)
#pragma unroll
            for (int i = 0; i < 4; ++i) out[(size_t)(rg * 16 + 4 * (lane >> 4) + i) * 80 + 16 * t + (lane & 15)] = acc[t][i]; }
}

template <bool COMBINE, bool ROUTE, bool XBF = false>
__device__ __forceinline__ void phase_norm_skinny(const void* __restrict__ xsrc_, void* __restrict__ xdst_, const bf16* __restrict__ Y, const int* __restrict__ tslot, const float* __restrict__ gain, const bf16* __restrict__ Wf, bf16* __restrict__ XNo, float* __restrict__ RSo, float* __restrict__ out80,
                                                  unsigned* cnt, int* __restrict__ asg_e, int* __restrict__ asg_pos, float* __restrict__ asg_w, LAS unsigned char* lds, int gw, int NGW, int wave, int lane, const float* __restrict__ gkr = nullptr, const float* __restrict__ ropet = nullptr, float* __restrict__ ssro = nullptr) {
    constexpr int AST = 528;
    LAS unsigned char* at = lds + wave * (8 * AST);
    LAS float* lg = (LAS float*)(lds + 8 * 8 * AST + wave * 2560);
    const int kq = lane >> 4;
    for (int g8 = gw; g8 < NTOK / 8; g8 += NGW) {
        const int row0 = g8 * 8;
        const float* __restrict__ xb = (const float*)xsrc_ + (size_t)row0 * DM + 4 * lane; const bf16* __restrict__ xbh = (const bf16*)xsrc_ + (size_t)row0 * DM + 4 * lane;
        int s0[8], s1[8];
        if (COMBINE) {
#pragma unroll
            for (int r = 0; r < 8; ++r) { s0[r] = __builtin_amdgcn_readfirstlane(tslot[2 * (row0 + r)]); s1[r] = __builtin_amdgcn_readfirstlane(tslot[2 * (row0 + r) + 1]); } }
        float ssr[8];
#pragma unroll
        for (int r = 0; r < 8; ++r) ssr[r] = 0.f;
        f32x4 acc[5];
#pragma unroll
        for (int t = 0; t < 5; ++t) acc[t] = (f32x4){0.f, 0.f, 0.f, 0.f};
        f32x4 xv[8]; v2u ya[8], yb[8], xh[8]; bf16x8 wf[2][2][5]; f32x4 g4;
        const bf16* __restrict__ yl = Y + 4 * lane; const float* __restrict__ gl = gain + 4 * lane; bf16* __restrict__ xnl = XNo + (size_t)row0 * DM + 4 * lane; float* __restrict__ xdl = (COMBINE && !XBF) ? (float*)xdst_ + (size_t)row0 * DM + 4 * lane : nullptr; bf16* __restrict__ xdh = (COMBINE && XBF) ? (bf16*)xdst_ + (size_t)row0 * DM + 4 * lane : nullptr;
#define FNS_LOADX(c_) do { int co_ = 256 * (c_); asm volatile("" : "+s"(co_));        \
            _Pragma("unroll") for (int r = 0; r < 8; ++r) { if (XBF) xh[r] = __builtin_nontemporal_load((const GAS v2u*)(xbh + (r * DM + co_))); else xv[r] = __builtin_nontemporal_load((const GAS f32x4*)(xb + (r * DM + co_))); \
            if (COMBINE) { ya[r] = __builtin_nontemporal_load((const GAS v2u*)(yl + ((size_t)s0[r] * DM + co_))); yb[r] = __builtin_nontemporal_load((const GAS v2u*)(yl + ((size_t)s1[r] * DM + co_))); } } \
            g4 = *(const GAS f32x4*)(gl + co_); } while (0)
#define FNS_LOADW(buf, gb_) do { const bf16* __restrict__ wp_ = Wf + ((size_t)(2 * (gb_)) * 5 * 64 + lane) * 8; \
            _Pragma("unroll") for (int s = 0; s < 2; ++s) _Pragma("unroll") for (int t = 0; t < 5; ++t) wf[buf][s][t] = *(const GAS bf16x8*)(wp_ + (size_t)(s * 5 + t) * 512); } while (0)
        if (!COMBINE) FNS_LOADX(0);
        FNS_LOADW(0, 0);
#pragma unroll 1
        for (int c = 0; c < 8; ++c) {
            if (COMBINE) FNS_LOADX(c);
            __builtin_amdgcn_sched_barrier(0);
            int cs_ = 256 * c; asm volatile("" : "+s"(cs_));
#pragma unroll
            for (int r = 0; r < 8; ++r) { f32x4 a; if (XBF) a = (f32x4){bflo(xh[r].x), bfhi(xh[r].x), bflo(xh[r].y), bfhi(xh[r].y)}; else a = xv[r];
                if (COMBINE) { a.x += bflo(ya[r].x) + bflo(yb[r].x); a.y += bfhi(ya[r].x) + bfhi(yb[r].x); a.z += bflo(ya[r].y) + bflo(yb[r].y); a.w += bfhi(ya[r].y) + bfhi(yb[r].y);
                    if (XBF) { v2u xo; xo.x = pk2(a.x, a.y); xo.y = pk2(a.z, a.w); *(GAS v2u*)(xdh + (r * DM + cs_)) = xo; } else *(GAS f32x4*)(xdl + (r * DM + cs_)) = a; }
                ssr[r] += (a.x * a.x + a.y * a.y) + (a.z * a.z + a.w * a.w);
                v2u p; p.x = pk2(a.x * g4.x, a.y * g4.y); p.y = pk2(a.z * g4.z, a.w * g4.w);
                if (!(ROUTE && XBF)) *(GAS v2u*)(xnl + (r * DM + cs_)) = p;
                *(LAS v2u*)(at + r * AST + 8 * lane) = p; }
            LDS_WAIT(); __builtin_amdgcn_sched_barrier(0);
            if (!COMBINE && c + 1 < 8) FNS_LOADX(c + 1);
            const LAS unsigned char* ap = at + (lane & 7) * AST + 16 * kq;
#pragma unroll
            for (int q = 0; q < 4; ++q) {
                if (4 * c + q + 1 < 32) FNS_LOADW((q + 1) & 1, 4 * c + q + 1);
                __builtin_amdgcn_sched_barrier(0);
#pragma unroll
                for (int s = 0; s < 2; ++s) { const bf16x8 af = *(const LAS bf16x8*)(ap + 64 * (2 * q + s));
#pragma unroll
                    for (int t = 0; t < 5; ++t) acc[t] = __builtin_amdgcn_mfma_f32_16x16x32_bf16(af, wf[q & 1][s][t], acc[t], 0, 0, 0); }
                __builtin_amdgcn_sched_barrier(0); }
            LDS_WAIT(); __builtin_amdgcn_sched_barrier(0); }
#undef FNS_LOADX
#undef FNS_LOADW
        float rr[8];
#pragma unroll
        for (int r = 0; r < 8; ++r) rr[r] = 1.0f / sqrtf(wave_sum(ssr[r], lane) * (1.0f / DM) + EPS);
        if (lane < 8) { float rv = rr[0];
#pragma unroll
            for (int r = 1; r < 8; ++r) rv = (lane == r) ? rr[r] : rv;
            RSo[row0 + lane] = rv; }
#pragma unroll
        for (int i = 0; i < 4; ++i) { const float ri = (lane < 16) ? rr[i] : rr[4 + i];
#pragma unroll
            for (int t = 0; t < 5; ++t) acc[t][i] *= ri; }
        if (!ROUTE) {
            const int jl = lane & 15, rbase = row0 + 4 * (lane >> 4);
#pragma unroll
            for (int i = 0; i < 4; ++i) { float sq = (acc[0][i] * acc[0][i] + acc[1][i] * acc[1][i]) + (acc[2][i] * acc[2][i] + acc[3][i] * acc[3][i]);
                sq += bperm_xor(sq, 1, lane); sq += bperm_xor(sq, 2, lane); sq += bperm_xor(sq, 4, lane); sq += bperm_xor(sq, 8, lane);
                if (lane < 32 && jl == 0) ssro[rbase + i] = sq; }
            if (lane < 32) {
#pragma unroll
                for (int t = 0; t < 2; ++t) { const int jj = 16 * t + jl; const float g1 = gkr[jj], g2 = gkr[32 + jj];
#pragma unroll
                    for (int i = 0; i < 4; ++i) { const size_t rw = (size_t)(rbase + i); const float cc = ropet[rw * 32 + jj], sv = ropet[(size_t)NTOK * 32 + rw * 32 + jj];
                        const float x1 = acc[t][i] * g1, x2 = acc[t + 2][i] * g2;
                        out80[rw * 80 + jj] = x1 * cc - x2 * sv; out80[rw * 80 + 32 + jj] = x2 * cc + x1 * sv; } }
#pragma unroll
                for (int i = 0; i < 4; ++i) out80[(size_t)(rbase + i) * 80 + 64 + jl] = acc[4][i]; } }
        else {
            if (lane < 32) {
#pragma unroll
                for (int t = 0; t < 5; ++t)
#pragma unroll
                    for (int i = 0; i < 4; ++i) lg[(4 * (lane >> 4) + i) * 80 + 16 * t + (lane & 15)] = acc[t][i]; }
            LDS_WAIT(); asm volatile("" ::: "memory");
            if (lane < 8) { const LAS float* L = lg + lane * 80; const int rw = row0 + lane;
                float gm = L[0]; int gi = 0;
#pragma unroll
                for (int j = 1; j < 8; ++j) { const float v = L[j]; if (v > gm) { gm = v; gi = j; } }
                float den = 0.f;
#pragma unroll
                for (int j = 0; j < 8; ++j) den += expf(L[j] - gm);
                const float pg = 1.0f / den;
                const LAS float* E = L + 8 + 8 * gi; float v0 = E[0]; int i0 = 0;
#pragma unroll
                for (int j = 1; j < 8; ++j) { const float v = E[j]; if (v > v0) { v0 = v; i0 = j; } }
                float v1 = -INFINITY; int i1 = 0;
#pragma unroll
                for (int j = 0; j < 8; ++j) { const float v = E[j]; if (j != i0 && v > v1) { v1 = v; i1 = j; } }
                const float e1 = expf(v1 - v0), w0 = pg / (1.0f + e1), w1 = pg * e1 / (1.0f + e1);
                const int x0 = gi * 8 + i0, x1 = gi * 8 + i1;
                const int p0 = (int)atomicAdd(cnt + x0, 1u), p1 = (int)atomicAdd(cnt + x1, 1u);
                asg_e[2 * rw] = x0; asg_pos[2 * rw] = p0; asg_w[2 * rw] = w0; asg_e[2 * rw + 1] = x1; asg_pos[2 * rw + 1] = p1; asg_w[2 * rw + 1] = w1; }
            LDS_WAIT(); asm volatile("" ::: "memory");
        }
    }
}

__device__ __forceinline__ void phase_post_proj(unsigned char* ws, const float* g_cq, const float* g_ckv, const float* g_sbq, const float* g_sbk,
                                                const float* g_fq, const float* g_fk, int gw, int NGW, int lane) {
    for (int it = gw; it < 2 * NTOK; it += NGW) { const int which = it & 1, row = it >> 1;
        bf16* p = (bf16*)(ws + (which ? WS_CKV : WS_CQ)) + (size_t)row * 512 + 8 * lane; const float* g = (which ? g_ckv : g_cq) + 8 * lane;
        const v4u w = *(const GAS v4u*)p; float v[8] = {bflo(w.x), bfhi(w.x), bflo(w.y), bfhi(w.y), bflo(w.z), bfhi(w.z), bflo(w.w), bfhi(w.w)};
        float s = 0.f;
#pragma unroll
        for (int i = 0; i < 8; ++i) s += v[i] * v[i];
        const float r = 1.0f / sqrtf(wave_sum(s, lane) * (1.0f / 512.f) + EPS);
        v4u o; o.x = pk2(v[0] * r * g[0], v[1] * r * g[1]); o.y = pk2(v[2] * r * g[2], v[3] * r * g[3]); o.z = pk2(v[4] * r * g[4], v[5] * r * g[5]); o.w = pk2(v[6] * r * g[6], v[7] * r * g[7]);
        *(GAS v4u*)p = o; }
    for (int it = gw; it < 4 * NTOK; it += NGW) { const int which = it & 3, row = it >> 2; const int seg = (which & 1) + 3 * (which >> 1);
        bf16* p = (bf16*)(ws + WS_QKV6) + (size_t)seg * NTOK * 1024 + (size_t)row * 1024 + 16 * lane;
        const float* g = (which == 0 ? g_sbq : which == 1 ? g_sbk : which == 2 ? g_fq : g_fk) + 16 * (lane & 3);
        const float qs = (which & 1) ? 1.0f : 0.125f * LOG2E;
        const v4u w0 = *(const GAS v4u*)p, w1 = *(const GAS v4u*)(p + 8);
        float v[16] = {bflo(w0.x), bfhi(w0.x), bflo(w0.y), bfhi(w0.y), bflo(w0.z), bfhi(w0.z), bflo(w0.w), bfhi(w0.w), bflo(w1.x), bfhi(w1.x), bflo(w1.y), bfhi(w1.y), bflo(w1.z), bfhi(w1.z), bflo(w1.w), bfhi(w1.w)};
        float s = 0.f;
#pragma unroll
        for (int i = 0; i < 16; ++i) s += v[i] * v[i];
        s += bperm_xor(s, 1, lane); s += bperm_xor(s, 2, lane);
        const float r = qs / sqrtf(s * (1.0f / 64.f) + EPS);
        v4u o0, o1; o0.x = pk2(v[0] * r * g[0], v[1] * r * g[1]); o0.y = pk2(v[2] * r * g[2], v[3] * r * g[3]); o0.z = pk2(v[4] * r * g[4], v[5] * r * g[5]); o0.w = pk2(v[6] * r * g[6], v[7] * r * g[7]);
        o1.x = pk2(v[8] * r * g[8], v[9] * r * g[9]); o1.y = pk2(v[10] * r * g[10], v[11] * r * g[11]); o1.z = pk2(v[12] * r * g[12], v[13] * r * g[13]); o1.w = pk2(v[14] * r * g[14], v[15] * r * g[15]);
        *(GAS v4u*)p = o0; *(GAS v4u*)(p + 8) = o1; }
}

__device__ __forceinline__ void phase_rope(unsigned char* ws, const int* positions, int tid_g, int nthr_g) {
    float* cs = (float*)(ws + WS_ROPE); float* sn = cs + (size_t)NTOK * 32;
    for (int i = tid_g; i < NTOK * 32; i += nthr_g) { const int row = i >> 5, j = i & 31; const float inv = powf(10000.0f, -(float)(2 * j) / 64.0f); const float ang = (float)positions[row] * inv;
        cs[i] = cosf(ang); sn[i] = sinf(ang); }
}
__device__ __forceinline__ void phase_cumsum(unsigned char* ws, const float* f_bias, LAS unsigned char* lds, int vcu, int G, int tid, int lane) {
    LAS float* wt = (LAS float*)lds;
    for (int seq = vcu; seq < NBATCH * NH; seq += G) { const int b = seq >> 4, h = seq & 15; const float* sk = (const float*)(ws + WS_SK) + (size_t)(b * SEQ + 8 * tid) * 80 + 64 + h; const float fb = f_bias[h];
        float v[8];
#pragma unroll
        for (int i = 0; i < 8; ++i) v[i] = sk[i * 80];
        float run = 0.f;
#pragma unroll
        for (int i = 0; i < 8; ++i) { run -= __builtin_amdgcn_logf(1.0f + __builtin_amdgcn_exp2f(-LOG2E * (v[i] + fb))); v[i] = run; }
        float inc = run;
#pragma unroll
        for (int o = 1; o < 64; o <<= 1) { const float t2 = bperm_up(inc, o, lane); if (lane >= o) inc += t2; }
        if (lane == 63) wt[tid >> 6] = inc;
        __syncthreads();
        float base = inc - run;
        for (int w = 0; w < (tid >> 6); ++w) base += wt[w];
        float* cf = (float*)(ws + WS_CUMF) + (size_t)seq * SEQ + 8 * tid;
        *(GAS f32x4*)cf = (f32x4){base + v[0], base + v[1], base + v[2], base + v[3]}; *(GAS f32x4*)(cf + 4) = (f32x4){base + v[4], base + v[5], base + v[6], base + v[7]};
        __syncthreads(); }
}

__device__ __forceinline__ void phase_mla_finalize(unsigned char* ws, const float* __restrict__ g_k, int gw, int NGW, int lane) {
    const int head = lane >> 2, c = lane & 3;
    const float* __restrict__ cs = (const float*)(ws + WS_ROPE); const float* __restrict__ sn = cs + (size_t)NTOK * 32; const float* __restrict__ sk = (const float*)(ws + WS_SK);
    bf16* KM = (bf16*)(ws + WS_KM); const bf16* __restrict__ KN = (const bf16*)(ws + WS_KNOPE);
    f32x4 gk[12];
#pragma unroll
    for (int i = 0; i < 8; ++i) gk[i] = *(const GAS f32x4*)(g_k + 32 * c + 4 * i);
#pragma unroll
    for (int i = 0; i < 2; ++i) { gk[8 + i] = *(const GAS f32x4*)(g_k + 128 + 8 * c + 4 * i); gk[10 + i] = *(const GAS f32x4*)(g_k + 160 + 8 * c + 4 * i); }
    for (int row0 = 2 * gw; row0 < NTOK; row0 += 2 * NGW) {
        v4u kw[2][4]; f32x4 cv[2][2], sv[2][2], kr[2][4];
#pragma unroll
        for (int q = 0; q < 2; ++q) { const int row = row0 + q; const bf16* kn = KN + (size_t)row * 2048 + head * 128 + 32 * c;
#pragma unroll
            for (int j = 0; j < 4; ++j) kw[q][j] = *(const GAS v4u*)(kn + 8 * j);
#pragma unroll
            for (int i = 0; i < 2; ++i) { cv[q][i] = *(const GAS f32x4*)(cs + (size_t)row * 32 + 8 * c + 4 * i); sv[q][i] = *(const GAS f32x4*)(sn + (size_t)row * 32 + 8 * c + 4 * i);
                kr[q][i] = *(const GAS f32x4*)(sk + (size_t)row * 80 + 8 * c + 4 * i); kr[q][2 + i] = *(const GAS f32x4*)(sk + (size_t)row * 80 + 32 + 8 * c + 4 * i); } }
        __builtin_amdgcn_sched_barrier(0);
#pragma unroll
        for (int q = 0; q < 2; ++q) { bf16* kb_ = KM + (size_t)(row0 + q) * 3072 + head * 192; float v[48];
#pragma unroll
            for (int j = 0; j < 4; ++j) { const v4u w = kw[q][j]; v[8 * j] = bflo(w.x); v[8 * j + 1] = bfhi(w.x); v[8 * j + 2] = bflo(w.y); v[8 * j + 3] = bfhi(w.y); v[8 * j + 4] = bflo(w.z); v[8 * j + 5] = bfhi(w.z); v[8 * j + 6] = bflo(w.w); v[8 * j + 7] = bfhi(w.w); }
#pragma unroll
            for (int i = 0; i < 8; ++i) { v[32 + i] = kr[q][i >> 2][i & 3]; v[40 + i] = kr[q][2 + (i >> 2)][i & 3]; }
            float s = 0.f;
#pragma unroll
            for (int i = 0; i < 48; ++i) s += v[i] * v[i];
            s += bperm_xor(s, 1, lane); s += bperm_xor(s, 2, lane);
            const float r = 1.0f / sqrtf(s * (1.0f / 192.f) + EPS);
#pragma unroll
            for (int j = 0; j < 4; ++j) { v4u o; const f32x4 g0 = gk[2 * j], g1 = gk[2 * j + 1]; const float* x = v + 8 * j;
                o.x = pk2(x[0] * r * g0[0], x[1] * r * g0[1]); o.y = pk2(x[2] * r * g0[2], x[3] * r * g0[3]); o.z = pk2(x[4] * r * g1[0], x[5] * r * g1[1]); o.w = pk2(x[6] * r * g1[2], x[7] * r * g1[3]);
                *(GAS v4u*)(kb_ + 32 * c + 8 * j) = o; }
            float o1[8], o2[8];
#pragma unroll
            for (int i = 0; i < 8; ++i) { const float x1 = v[32 + i] * r * gk[8 + (i >> 2)][i & 3], x2 = v[40 + i] * r * gk[10 + (i >> 2)][i & 3], cc = cv[q][i >> 2][i & 3], ss = sv[q][i >> 2][i & 3]; o1[i] = x1 * cc - x2 * ss; o2[i] = x2 * cc + x1 * ss; }
            v4u a, b2; a.x = pk2(o1[0], o1[1]); a.y = pk2(o1[2], o1[3]); a.z = pk2(o1[4], o1[5]); a.w = pk2(o1[6], o1[7]); b2.x = pk2(o2[0], o2[1]); b2.y = pk2(o2[2], o2[3]); b2.z = pk2(o2[4], o2[5]); b2.w = pk2(o2[6], o2[7]);
            *(GAS v4u*)(kb_ + 128 + 8 * c) = a; *(GAS v4u*)(kb_ + 160 + 8 * c) = b2; }
        __builtin_amdgcn_sched_barrier(0);
    }
}

__device__ __forceinline__ void phase_route(unsigned char* ws, unsigned* cnt, LAS unsigned char* lds, int gw, int NGW, int wave, int lane) {
    const bf16* H = (const bf16*)(ws + WS_XN); const bf16* WRT = (const bf16*)(ws + WS_WRT);
    int* asg_e = (int*)(ws + WS_ASG); int* asg_pos = asg_e + NASG; float* asg_w = (float*)(asg_pos + NASG);
    LAS float* lg = (LAS float*)(lds + wave * 8192);
    for (int rg = gw; rg < NTOK / 16; rg += NGW) { f32x4 acc[5]; skinny16x80(H, WRT, rg * 16, lane, acc);
#pragma unroll
        for (int t = 0; t < 5; ++t)
#pragma unroll
            for (int i = 0; i < 4; ++i) lg[(4 * (lane >> 4) + i) * 80 + 16 * t + (lane & 15)] = acc[t][i];
        LDS_WAIT(); asm volatile("" ::: "memory");
        if (lane < 16) { const LAS float* L = lg + lane * 80; const int row = rg * 16 + lane;
            float gm = L[0]; int gi = 0;
#pragma unroll
            for (int j = 1; j < 8; ++j) { const float v = L[j]; if (v > gm) { gm = v; gi = j; } }
            float den = 0.f;
#pragma unroll
            for (int j = 0; j < 8; ++j) den += expf(L[j] - gm);
            const float pg = 1.0f / den;
            const LAS float* E = L + 8 + 8 * gi; float v0 = E[0]; int i0 = 0;
#pragma unroll
            for (int j = 1; j < 8; ++j) { const float v = E[j]; if (v > v0) { v0 = v; i0 = j; } }
            float v1 = -INFINITY; int i1 = 0;
#pragma unroll
            for (int j = 0; j < 8; ++j) { const float v = E[j]; if (j != i0 && v > v1) { v1 = v; i1 = j; } }
            const float e1 = expf(v1 - v0), w0 = pg / (1.0f + e1), w1 = pg * e1 / (1.0f + e1);
            const int x0 = gi * 8 + i0, x1 = gi * 8 + i1;
            const int p0 = (int)atomicAdd(cnt + x0, 1u), p1 = (int)atomicAdd(cnt + x1, 1u);
            asg_e[2 * row] = x0; asg_pos[2 * row] = p0; asg_w[2 * row] = w0; asg_e[2 * row + 1] = x1; asg_pos[2 * row + 1] = p1; asg_w[2 * row + 1] = w1; }
        LDS_WAIT(); asm volatile("" ::: "memory");
    }
}

__device__ __forceinline__ void phase_dispatch(unsigned char* ws, const bf16* __restrict__ xs, const float* __restrict__ gain, const unsigned* cnt, LAS unsigned char* lds, int gw, int NGW, int tid, int lane, int block) {
    LAS int* off = (LAS int*)lds;
    LAS int* cl = off + 72;
    if (tid < NEXP) cl[tid] = (int)__hip_atomic_load(cnt + tid, __ATOMIC_RELAXED, __HIP_MEMORY_SCOPE_AGENT);
    __syncthreads();
    if (tid == 0) { int a = 0; for (int e = 0; e < NEXP; ++e) { off[e] = a; a += ((cl[e] + 255) >> 8) << 8; } off[NEXP] = a; }
    __syncthreads();
    int* tile_e = (int*)(ws + WS_TAB); int* nrt_p = tile_e + 256;
    if (block == 0) { const int nrt = off[NEXP] >> 8; if (tid == 0) *nrt_p = nrt;
        for (int R = tid; R < nrt; R += NWAVES * 64) { int e = 0; while (e < NEXP - 1 && off[e + 1] <= 256 * R) ++e; tile_e[R] = e; }
        if (tid < NEXP) tile_e[400 + tid] = off[tid] >> 8;
        if (tid < 8) { int a = 0; for (int k = 0; k < 8; ++k) { tile_e[320 + 9 * tid + k] = a; a += (off[tid + 8 * k + 1] - off[tid + 8 * k]) >> 8; } tile_e[320 + 9 * tid + 8] = a; } }
    const int* asg_e = (const int*)(ws + WS_ASG); const int* asg_pos = asg_e + NASG; const float* asg_w = (const float*)(asg_pos + NASG);
    int* tslot = (int*)(asg_w + NASG); float* slot_w = (float*)(tslot + NASG); float* slot_r = slot_w + MAXSLOT; const float* RS2 = (const float*)(ws + WS_RS2);
    const bf16* H = xs; bf16* HS = (bf16*)(ws + WS_HS);
    f32x4 gg[4][2];
#pragma unroll
    for (int j = 0; j < 4; ++j) { gg[j][0] = *(const GAS f32x4*)(gain + 8 * (lane + 64 * j)); gg[j][1] = *(const GAS f32x4*)(gain + 8 * (lane + 64 * j) + 4); }
    for (int tok = 4 * gw; tok < NTOK; tok += 4 * NGW) {
        int sl[4][2]; v4u rv[4][4];
        { const v4u e0 = *(const GAS v4u*)(asg_e + 2 * tok), e1 = *(const GAS v4u*)(asg_e + 2 * tok + 4), p0 = *(const GAS v4u*)(asg_pos + 2 * tok), p1 = *(const GAS v4u*)(asg_pos + 2 * tok + 4);
          const unsigned ev[8] = {e0.x, e0.y, e0.z, e0.w, e1.x, e1.y, e1.z, e1.w}, pv[8] = {p0.x, p0.y, p0.z, p0.w, p1.x, p1.y, p1.z, p1.w};
#pragma unroll
          for (int a = 0; a < 8; ++a) sl[a >> 1][a & 1] = off[__builtin_amdgcn_readfirstlane((int)ev[a])] + __builtin_amdgcn_readfirstlane((int)pv[a]); }
#pragma unroll
        for (int q = 0; q < 4; ++q) { const GAS v4u* s = (const GAS v4u*)(H + (size_t)(tok + q) * DM) + lane;
#pragma unroll
            for (int j = 0; j < 4; ++j) rv[q][j] = __builtin_nontemporal_load(s + 64 * j); }
        __builtin_amdgcn_sched_barrier(0);
#pragma unroll
        for (int q = 0; q < 4; ++q)
#pragma unroll
            for (int j = 0; j < 4; ++j) { const v4u w = rv[q][j]; const f32x4 g0 = gg[j][0], g1 = gg[j][1]; v4u o;
                o.x = pk2(bflo(w.x) * g0[0], bfhi(w.x) * g0[1]); o.y = pk2(bflo(w.y) * g0[2], bfhi(w.y) * g0[3]); o.z = pk2(bflo(w.z) * g1[0], bfhi(w.z) * g1[1]); o.w = pk2(bflo(w.w) * g1[2], bfhi(w.w) * g1[3]); rv[q][j] = o; }
#pragma unroll
        for (int q = 0; q < 4; ++q)
#pragma unroll
            for (int k = 0; k < 2; ++k) { GAS v4u* d = (GAS v4u*)(HS + (size_t)sl[q][k] * DM) + lane;
#pragma unroll
                for (int j = 0; j < 4; ++j) d[64 * j] = rv[q][j];
                if (lane == 0) { const int a = 2 * (tok + q) + k; slot_w[sl[q][k]] = asg_w[a]; slot_r[sl[q][k]] = RS2[tok + q]; tslot[a] = sl[q][k]; } }
        __builtin_amdgcn_sched_barrier(0); }
    __syncthreads();
}

__device__ __forceinline__ void phase_combine(unsigned char* ws, const bf16* xs, float* x, int gw, int NGW, int lane) {
    const int* tslot = (const int*)(ws + WS_ASG) + 3 * NASG; const bf16* Y = (const bf16*)(ws + WS_Y);
    for (int row = 2 * gw; row < NTOK; row += 2 * NGW) { const v4u sv = *(const GAS v4u*)(tslot + 2 * row);
        const int s[4] = {__builtin_amdgcn_readfirstlane((int)sv.x), __builtin_amdgcn_readfirstlane((int)sv.y), __builtin_amdgcn_readfirstlane((int)sv.z), __builtin_amdgcn_readfirstlane((int)sv.w)};
        v2u ya[2][8], yb[2][8], xv[2][8];
#pragma unroll
        for (int q = 0; q < 2; ++q) { const GAS v2u* y0 = (const GAS v2u*)(Y + (size_t)s[2 * q] * DM) + lane; const GAS v2u* y1 = (const GAS v2u*)(Y + (size_t)s[2 * q + 1] * DM) + lane; const GAS v2u* xr = (const GAS v2u*)(xs + (size_t)(row + q) * DM) + lane;
#pragma unroll
            for (int j = 0; j < 8; ++j) { ya[q][j] = __builtin_nontemporal_load(y0 + 64 * j); yb[q][j] = __builtin_nontemporal_load(y1 + 64 * j); xv[q][j] = __builtin_nontemporal_load(xr + 64 * j); } }
        __builtin_amdgcn_sched_barrier(0);
#pragma unroll
        for (int q = 0; q < 2; ++q) { GAS f32x4* xr = (GAS f32x4*)(x + (size_t)(row + q) * DM) + lane;
#pragma unroll
            for (int j = 0; j < 8; ++j) { const v2u a = ya[q][j], b = yb[q][j], c = xv[q][j]; f32x4 v;
                v.x = bflo(c.x) + (bflo(a.x) + bflo(b.x)); v.y = bfhi(c.x) + (bfhi(a.x) + bfhi(b.x)); v.z = bflo(c.y) + (bflo(a.y) + bflo(b.y)); v.w = bfhi(c.y) + (bfhi(a.y) + bfhi(b.y)); __builtin_nontemporal_store(v, xr + 64 * j); } }
        __builtin_amdgcn_sched_barrier(0); }
}
__device__ __forceinline__ int crow(int r, int hi) { return (r & 3) + 8 * (r >> 2) + 4 * hi; }
template <int DK, int DV, int MODE>
__device__ __forceinline__ void attn_unit(LAS unsigned char* lds, const bf16* Qg, const bf16* Kg, const bf16* Vg, bf16* Og, int pqk, int pv, int b, int h, int qb, const float* ckg, float sbound, const float* gq = nullptr, const float* rope = nullptr) {
    constexpr int KST = DK * 2 + 16, VST = DV * 2 + 64;
    constexpr int KBYTES = 64 * KST, VBYTES = 64 * VST, STAGE = KBYTES + VBYTES + 256;
    constexpr int KCH = DK / 8, VCH = DV / 8, NKL = 64 * KCH / 512, NVL = 64 * VCH / 512;
    static_assert(2 * STAGE <= RING_BYTES, "attention LDS");
    int tid_ = threadIdx.x; asm volatile("" : "+v"(tid_));
    const int tid = tid_, lane = tid & 63, r32 = lane & 31, hi = lane >> 5; const int wid = __builtin_amdgcn_readfirstlane(tid >> 6);
    const size_t rowbase = (size_t)b * SEQ; const int q0 = qb * 256;
    bf16x8 qr[DK / 16];
    { const bf16* qp = Qg + (rowbase + q0 + wid * 32 + r32) * pqk + h * DK + 8 * hi;
#pragma unroll
      for (int d0 = 0; d0 < DK / 16; ++d0) qr[d0] = *(const GAS bf16x8*)(qp + 16 * d0); }
    if (DK == 192) {
        float qf[12][8]; float ss = 0.f;
#pragma unroll
        for (int d0 = 0; d0 < 12; ++d0) { const v4u w = __builtin_bit_cast(v4u, qr[d0]);
            qf[d0][0] = bflo(w.x); qf[d0][1] = bfhi(w.x); qf[d0][2] = bflo(w.y); qf[d0][3] = bfhi(w.y); qf[d0][4] = bflo(w.z); qf[d0][5] = bfhi(w.z); qf[d0][6] = bflo(w.w); qf[d0][7] = bfhi(w.w);
#pragma unroll
            for (int j = 0; j < 8; ++j) ss += qf[d0][j] * qf[d0][j]; }
        { auto rr = __builtin_amdgcn_permlane32_swap(__float_as_uint(ss), __float_as_uint(ss), false, false); ss = __uint_as_float(rr[0]) + __uint_as_float(rr[1]); }
        const float rn = (0.07216878364870322f * LOG2E) / sqrtf(ss * (1.0f / 192.f) + EPS);
        const float* gp = gq + 8 * hi; const float* cs = rope + (size_t)(rowbase + q0 + wid * 32 + r32) * 32 + 8 * hi; const float* sn = cs + (size_t)NTOK * 32;
#pragma unroll
        for (int d0 = 0; d0 < 8; ++d0) { const f32x4 g0 = *(const GAS f32x4*)(gp + 16 * d0), g1 = *(const GAS f32x4*)(gp + 16 * d0 + 4); v4u w;
            w.x = pk2(qf[d0][0] * rn * g0[0], qf[d0][1] * rn * g0[1]); w.y = pk2(qf[d0][2] * rn * g0[2], qf[d0][3] * rn * g0[3]); w.z = pk2(qf[d0][4] * rn * g1[0], qf[d0][5] * rn * g1[1]); w.w = pk2(qf[d0][6] * rn * g1[2], qf[d0][7] * rn * g1[3]);
            qr[d0] = __builtin_bit_cast(bf16x8, w); }
#pragma unroll
        for (int d0 = 8; d0 < 10; ++d0) { const f32x4 ga0 = *(const GAS f32x4*)(gp + 16 * d0), ga1 = *(const GAS f32x4*)(gp + 16 * d0 + 4), gb0 = *(const GAS f32x4*)(gp + 16 * d0 + 32), gb1 = *(const GAS f32x4*)(gp + 16 * d0 + 36);
            const f32x4 c0 = *(const GAS f32x4*)(cs + 16 * (d0 - 8)), c1 = *(const GAS f32x4*)(cs + 16 * (d0 - 8) + 4), s0 = *(const GAS f32x4*)(sn + 16 * (d0 - 8)), s1 = *(const GAS f32x4*)(sn + 16 * (d0 - 8) + 4);
            float o1[8], o2[8];
#pragma unroll
            for (int j = 0; j < 8; ++j) { const float x1 = qf[d0][j] * rn * (j < 4 ? ga0[j & 3] : ga1[j & 3]), x2 = qf[d0 + 2][j] * rn * (j < 4 ? gb0[j & 3] : gb1[j & 3]), cc = (j < 4 ? c0[j & 3] : c1[j & 3]), sv = (j < 4 ? s0[j & 3] : s1[j & 3]);
                o1[j] = x1 * cc - x2 * sv; o2[j] = x2 * cc + x1 * sv; }
            v4u wa, wb; wa.x = pk2(o1[0], o1[1]); wa.y = pk2(o1[2], o1[3]); wa.z = pk2(o1[4], o1[5]); wa.w = pk2(o1[6], o1[7]); wb.x = pk2(o2[0], o2[1]); wb.y = pk2(o2[2], o2[3]); wb.z = pk2(o2[4], o2[5]); wb.w = pk2(o2[6], o2[7]);
            qr[d0] = __builtin_bit_cast(bf16x8, wa); qr[d0 + 2] = __builtin_bit_cast(bf16x8, wb); }
    }
    f32x16 o[DV / 32];
#pragma unroll
    for (int i = 0; i < DV / 32; ++i) o[i] = (f32x16){};
    float mrun = -INFINITY, lrun = 0.f, Rrun = 0.f;
    bf16x8 utri[2], uone;
    if (MODE == 2) {
#pragma unroll
        for (int s = 0; s < 2; ++s)
#pragma unroll
            for (int j = 0; j < 8; ++j) { const int key = 16 * s + 8 * (j >> 2) + 4 * hi + (j & 3); utri[s][j] = (short)(key >= r32 ? 0x3F80 : 0); }
#pragma unroll
        for (int j = 0; j < 8; ++j) uone[j] = (short)0x3F80;
    }
    const int NT = 4 * qb + 4;
    v4u kreg[NKL], vreg[NVL]; float ckreg = 0.f;
    const bf16* Kh = Kg + rowbase * pqk + h * DK; const bf16* Vh = Vg + rowbase * pv + h * DV; const float* ckh = (MODE == 1) ? ckg + (size_t)(b * NH + h) * SEQ : nullptr;
#define ATT_LOAD(kt) do { \
        _Pragma("unroll") for (int i = 0; i < NKL; ++i) { const int c = tid + 512 * i, row = c / KCH, cc = c % KCH; kreg[i] = *(const GAS v4u*)(Kh + (size_t)((kt) * 64 + row) * pqk + cc * 8); } \
        _Pragma("unroll") for (int i = 0; i < NVL; ++i) { const int c = tid + 512 * i, row = c / VCH, cc = c % VCH; vreg[i] = *(const GAS v4u*)(Vh + (size_t)((kt) * 64 + row) * pv + cc * 8); } \
        if (MODE == 1 && tid < 64) ckreg = ckh[(kt) * 64 + tid]; } while (0)
#define ATT_STORE(st) do { \
        _Pragma("unroll") for (int i = 0; i < NKL; ++i) { const int c = tid + 512 * i, row = c / KCH, cc = c % KCH; *(LAS v4u*)((st) + row * KST + cc * 16) = kreg[i]; } \
        _Pragma("unroll") for (int i = 0; i < NVL; ++i) { const int c = tid + 512 * i, row = c / VCH, cc = c % VCH; *(LAS v4u*)((st) + KBYTES + row * VST + cc * 16) = vreg[i]; } \
        if (MODE == 1 && tid < 64) *(LAS float*)((st) + KBYTES + VBYTES + tid * 4) = ckreg; } while (0)
    ATT_LOAD(NT - 1); ATT_STORE(lds); __syncthreads();
    const int qrel = wid * 32 + r32;
    for (int it = 0; it < NT; ++it) {
        const int kt = NT - 1 - it; LAS unsigned char* st = lds + (it & 1) * STAGE; LAS unsigned char* stn = lds + ((it & 1) ^ 1) * STAGE;
        if (it + 1 < NT) ATT_LOAD(kt - 1);
        float cknext = 0.f; if (MODE == 1 && it + 1 < NT) cknext = ckh[(kt - 1) * 64 + 63];
        const int jb = kt - 4 * qb;
        if (!(jb >= 0 && 2 * jb > wid)) {
            f32x16 p0 = (f32x16){}, p1 = (f32x16){};
            {
              const LAS unsigned char* kb = st + r32 * KST + hi * 16;
              constexpr int NF = 2 * (DK / 16), FB = 4; bf16x8 kf[2][FB];
#pragma unroll
              for (int i = 0; i < FB; ++i) kf[0][i] = *(const LAS bf16x8*)(kb + (i & 1) * 32 * KST + (i >> 1) * 32);
#pragma unroll
              for (int bq = 0; bq < NF / FB; ++bq) {
                  if (bq + 1 < NF / FB) {
#pragma unroll
                      for (int i = 0; i < FB; ++i) { const int f = (bq + 1) * FB + i; kf[(bq + 1) & 1][i] = *(const LAS bf16x8*)(kb + (f & 1) * 32 * KST + (f >> 1) * 32); } }
                  __builtin_amdgcn_sched_barrier(0); __builtin_amdgcn_s_setprio(1);
#pragma unroll
                  for (int i = 0; i < FB; ++i) { const int f = bq * FB + i;
                      if (f & 1) p1 = __builtin_amdgcn_mfma_f32_32x32x16_bf16(kf[bq & 1][i], qr[f >> 1], p1, 0, 0, 0);
                      else p0 = __builtin_amdgcn_mfma_f32_32x32x16_bf16(kf[bq & 1][i], qr[f >> 1], p0, 0, 0, 0); }
                  __builtin_amdgcn_s_setprio(0); __builtin_amdgcn_sched_barrier(0); } }
            if (MODE != 2) {
                if (MODE == 1) { const LAS float* cks = (const LAS float*)(st + KBYTES + VBYTES);
#pragma unroll
                    for (int g = 0; g < 4; ++g) { const f32x4 c0 = *(const LAS f32x4*)(cks + 8 * g + 4 * hi), c1 = *(const LAS f32x4*)(cks + 32 + 8 * g + 4 * hi);
#pragma unroll
                        for (int i = 0; i < 4; ++i) { p0[4 * g + i] -= c0[i]; p1[4 * g + i] -= c1[i]; } } }
                if (jb >= 0) {
#pragma unroll
                    for (int r = 0; r < 16; ++r) { const int kv = 64 * jb + crow(r, hi); if (kv > qrel) p0[r] = -INFINITY; if (kv + 32 > qrel) p1[r] = -INFINITY; } }
                float mx = p0[0];
#pragma unroll
                for (int r = 1; r < 16; ++r) mx = fmaxf(mx, p0[r]);
#pragma unroll
                for (int r = 0; r < 16; ++r) mx = fmaxf(mx, p1[r]);
                { auto rr = __builtin_amdgcn_permlane32_swap(__float_as_uint(mx), __float_as_uint(mx), false, false); mx = fmaxf(__uint_as_float(rr[0]), __uint_as_float(rr[1])); }
                if (__any(mx - mrun > 8.0f)) { const float mnew = fmaxf(mrun, mx), alpha = __builtin_amdgcn_exp2f(mrun - mnew); mrun = mnew; lrun *= alpha;
#pragma unroll
                    for (int i = 0; i < DV / 32; ++i) o[i] *= alpha; }
                float sum = 0.f;
#pragma unroll
                for (int r = 0; r < 16; ++r) { p0[r] = __builtin_amdgcn_exp2f(p0[r] - mrun); p1[r] = __builtin_amdgcn_exp2f(p1[r] - mrun); sum += p0[r] + p1[r]; }
                lrun += sum;
            } else {
                f32x16 l0, l1;
#pragma unroll
                for (int r = 0; r < 16; ++r) { l0[r] = __builtin_amdgcn_logf(1.0f + __builtin_amdgcn_exp2f(p0[r])); l1[r] = __builtin_amdgcn_logf(1.0f + __builtin_amdgcn_exp2f(p1[r])); }
                if (jb >= 0) {
#pragma unroll
                    for (int r = 0; r < 16; ++r) { const int kv = 64 * jb + crow(r, hi); if (kv >= qrel) l0[r] = 0.f; if (kv + 32 >= qrel) l1[r] = 0.f; } }
                v4u lb[4];
#pragma unroll
                for (int s = 0; s < 2; ++s) { lb[s].x = pg8::cvt_pk_bf16(l0[8 * s], l0[8 * s + 1]); lb[s].y = pg8::cvt_pk_bf16(l0[8 * s + 2], l0[8 * s + 3]); lb[s].z = pg8::cvt_pk_bf16(l0[8 * s + 4], l0[8 * s + 5]); lb[s].w = pg8::cvt_pk_bf16(l0[8 * s + 6], l0[8 * s + 7]);
                    lb[2 + s].x = pg8::cvt_pk_bf16(l1[8 * s], l1[8 * s + 1]); lb[2 + s].y = pg8::cvt_pk_bf16(l1[8 * s + 2], l1[8 * s + 3]); lb[2 + s].z = pg8::cvt_pk_bf16(l1[8 * s + 4], l1[8 * s + 5]); lb[2 + s].w = pg8::cvt_pk_bf16(l1[8 * s + 6], l1[8 * s + 7]); }
                f32x16 c0, c1;
#pragma unroll
                for (int r = 0; r < 16; ++r) { c0[r] = Rrun; c1[r] = Rrun; }
                c0 = __builtin_amdgcn_mfma_f32_32x32x16_bf16(utri[0], __builtin_bit_cast(bf16x8, lb[0]), c0, 0, 0, 0);
                c0 = __builtin_amdgcn_mfma_f32_32x32x16_bf16(utri[1], __builtin_bit_cast(bf16x8, lb[1]), c0, 0, 0, 0);
                c0 = __builtin_amdgcn_mfma_f32_32x32x16_bf16(uone, __builtin_bit_cast(bf16x8, lb[2]), c0, 0, 0, 0);
                c0 = __builtin_amdgcn_mfma_f32_32x32x16_bf16(uone, __builtin_bit_cast(bf16x8, lb[3]), c0, 0, 0, 0);
                c1 = __builtin_amdgcn_mfma_f32_32x32x16_bf16(utri[0], __builtin_bit_cast(bf16x8, lb[2]), c1, 0, 0, 0);
                c1 = __builtin_amdgcn_mfma_f32_32x32x16_bf16(utri[1], __builtin_bit_cast(bf16x8, lb[3]), c1, 0, 0, 0);
#pragma unroll
                for (int r = 0; r < 16; ++r) { p0[r] = __builtin_amdgcn_exp2f(p0[r] - c0[r]); p1[r] = __builtin_amdgcn_exp2f(p1[r] - c1[r]); }
                if (jb >= 0) {
#pragma unroll
                    for (int r = 0; r < 16; ++r) { const int kv = 64 * jb + crow(r, hi); if (kv >= qrel) p0[r] = 0.f; if (kv + 32 >= qrel) p1[r] = 0.f; } }
                { auto rr = __builtin_amdgcn_permlane32_swap(__float_as_uint(c0[0]), __float_as_uint(c0[0]), false, false); Rrun = __uint_as_float(rr[0]); }
            }
            v4u pb[4];
#pragma unroll
            for (int s = 0; s < 2; ++s) { pb[s].x = pg8::cvt_pk_bf16(p0[8 * s], p0[8 * s + 1]); pb[s].y = pg8::cvt_pk_bf16(p0[8 * s + 2], p0[8 * s + 3]); pb[s].z = pg8::cvt_pk_bf16(p0[8 * s + 4], p0[8 * s + 5]); pb[s].w = pg8::cvt_pk_bf16(p0[8 * s + 6], p0[8 * s + 7]);
                pb[2 + s].x = pg8::cvt_pk_bf16(p1[8 * s], p1[8 * s + 1]); pb[2 + s].y = pg8::cvt_pk_bf16(p1[8 * s + 2], p1[8 * s + 3]); pb[2 + s].z = pg8::cvt_pk_bf16(p1[8 * s + 4], p1[8 * s + 5]); pb[2 + s].w = pg8::cvt_pk_bf16(p1[8 * s + 6], p1[8 * s + 7]); }
            {
              const LAS unsigned char* vb = st + KBYTES + (4 * hi + ((lane & 15) >> 2)) * VST + ((lane >> 4) & 1) * 32 + (lane & 3) * 8;
              constexpr int NBLK = DV / 32, NP = NBLK * 4, PB = 4; s16x4 vt[2][PB][2];
#define ATT_VRD(buf, g) do { const LAS unsigned char* vp_ = vb + (16 * ((g) / NBLK)) * VST + ((g) % NBLK) * 64; \
                  vt[buf][(g) % PB][0] = __builtin_bit_cast(s16x4, __builtin_amdgcn_ds_read_tr16_b64_v4i16((LAS s16x4*)vp_)); \
                  vt[buf][(g) % PB][1] = __builtin_bit_cast(s16x4, __builtin_amdgcn_ds_read_tr16_b64_v4i16((LAS s16x4*)(vp_ + 8 * VST))); } while (0)
#pragma unroll
              for (int i = 0; i < PB; ++i) ATT_VRD(0, i);
#pragma unroll
              for (int bq = 0; bq < NP / PB; ++bq) {
                  if (bq + 1 < NP / PB) {
#pragma unroll
                      for (int i = 0; i < PB; ++i) ATT_VRD((bq + 1) & 1, (bq + 1) * PB + i); }
                  __builtin_amdgcn_sched_barrier(0); __builtin_amdgcn_s_setprio(1);
#pragma unroll
                  for (int i = 0; i < PB; ++i) { const int g = bq * PB + i; const s16x4 t0 = vt[bq & 1][i][0], t1 = vt[bq & 1][i][1];
                      const bf16x8 af = (bf16x8){t0[0], t0[1], t0[2], t0[3], t1[0], t1[1], t1[2], t1[3]};
                      o[g % NBLK] = __builtin_amdgcn_mfma_f32_32x32x16_bf16(af, __builtin_bit_cast(bf16x8, pb[g / NBLK]), o[g % NBLK], 0, 0, 0); }
                  __builtin_amdgcn_s_setprio(0); __builtin_amdgcn_sched_barrier(0); }
#undef ATT_VRD
            }
        }
        if (it + 1 < NT) ATT_STORE(stn);
        if (MODE == 2) {
            LAS unsigned* fl = (LAS unsigned*)(lds + RING_BYTES) + (it & 1) * 8;
            const bool wdone = __all(Rrun > 36.0f);
            if (lane == 0) fl[wid] = wdone ? 1u : 0u;
            __syncthreads();
            const v4u f0 = *(const LAS v4u*)fl, f1 = *(const LAS v4u*)(fl + 4);
            if ((f0.x & f0.y & f0.z & f0.w & f1.x & f1.y & f1.z & f1.w) != 0u) break;
        } else if (MODE == 1) {
            LAS unsigned* fl = (LAS unsigned*)(lds + RING_BYTES) + (it & 1) * 8;
            const bool wdone = __all(mrun - (sbound - cknext) > 36.0f);
            if (lane == 0) fl[wid] = wdone ? 1u : 0u;
            __syncthreads();
            const v4u f0 = *(const LAS v4u*)fl, f1 = *(const LAS v4u*)(fl + 4);
            if ((f0.x & f0.y & f0.z & f0.w & f1.x & f1.y & f1.z & f1.w) != 0u) break;
        } else __syncthreads();
    }
#undef ATT_LOAD
#undef ATT_STORE
    float inv = 1.0f;
    if (MODE != 2) { auto rr = __builtin_amdgcn_permlane32_swap(__float_as_uint(lrun), __float_as_uint(lrun), false, false); inv = 1.0f / (__uint_as_float(rr[0]) + __uint_as_float(rr[1])); }
    bf16* op = Og + (rowbase + q0 + wid * 32 + r32) * pv + h * DV + 4 * hi;
#pragma unroll
    for (int blk = 0; blk < DV / 32; ++blk)
#pragma unroll
        for (int g = 0; g < 4; ++g) { v2u w; w.x = pk2(o[blk][4 * g] * inv, o[blk][4 * g + 1] * inv); w.y = pk2(o[blk][4 * g + 2] * inv, o[blk][4 * g + 3] * inv); *(GAS v2u*)(op + 32 * blk + 8 * g) = w; }
}
struct Args { const void* in[25]; float* out; unsigned char* ws; int ph_lo, ph_hi; };
__global__ void __launch_bounds__(NWAVES * 64, 2) mk_fwd(Args args) {
    extern __shared__ __attribute__((aligned(16))) unsigned char lds_raw[];
    LAS unsigned char* lds = (LAS unsigned char*)lds_raw;
    volatile LAS unsigned* MISC = (volatile LAS unsigned*)(lds + MISC_OFF);
    const int G = gridDim.x, bx = blockIdx.x; const int vcu = (G % 8 == 0) ? (bx % 8) * (G / 8) + bx / 8 : bx;
    const int NGW = G * NWAVES, nthr_g = G * NWAVES * 64;
    unsigned char* ws = args.ws; gu32* ctl = (gu32*)(ws + WS_CTL);
    for (int u = threadIdx.x; u < (LDS_BYTES - LDSCTL_OFF) / 4; u += NWAVES * 64) ((LAS unsigned*)(lds + LDSCTL_OFF))[u] = 0u;
    __syncthreads();
    XcdBarrier bar = xcd_barrier_post((unsigned*)(ctl + CW_BAR), MISC + 8);
    const int lo = args.ph_lo, hi = args.ph_hi; int ph = 0;
#define PH_BEGIN if (lo <= ph && ph < hi) { int tid = threadIdx.x; asm volatile("" : "+v"(tid)); const int lane = tid & 63, wave = __builtin_amdgcn_readfirstlane(tid >> 6), gw = vcu * NWAVES + wave, tid_g = vcu * NWAVES * 64 + tid; (void)lane; (void)gw; (void)tid_g;
#define PH_END   if (ph + 1 < hi) xcd_barrier(bar); } ++ph;

#define XN ((bf16*)(ws + WS_XN))
#define CQ ((bf16*)(ws + WS_CQ))
#define CKV ((bf16*)(ws + WS_CKV))
#define QKV6 ((bf16*)(ws + WS_QKV6))
#define GATES ((bf16*)(ws + WS_GATES))
#define QM ((bf16*)(ws + WS_QM))
#define KM ((bf16*)(ws + WS_KM))
#define VM ((bf16*)(ws + WS_VM))
#define KNOPE ((bf16*)(ws + WS_KNOPE))
#define OA ((bf16*)(ws + WS_OA))
#define OB ((bf16*)(ws + WS_OB))
#define OC ((bf16*)(ws + WS_OC))
#define MF ((float*)(ws + WS_MF))
#define XOB ((bf16*)(ws + WS_MF))
#define XBB ((bf16*)(ws + WS_MF + 64 * MiB))
#define MB ((bf16*)(ws + WS_MB))
#define HS ((bf16*)(ws + WS_HS))
#define ACT ((bf16*)(ws + WS_ACT))
#define YB ((bf16*)(ws + WS_Y))
#define SEGS ((size_t)NTOK * 1024)
#define XSRC ((l == 0) ? (const float*)args.in[0] : (const float*)(ws + WS_XB))
#define XO (args.out)
#define POSITIONS ((const int*)args.in[1])

#pragma unroll 1
    for (int l = 0; l < DEPTH; ++l) {
        PH_BEGIN
            if (l == 0) {
                for (int l2 = 0; l2 < DEPTH; ++l2)
                    phase_convert_small((const float*)args.in[3] + (size_t)l2 * 2048 * DIN, (const float*)args.in[20] + (size_t)l2 * 2048 * 8, (const float*)args.in[21] + (size_t)l2 * 2048 * 64,
                                        (bf16*)(ws + WS_WSK) + (size_t)l2 * 80 * 2048, (bf16*)(ws + WS_WRT) + (size_t)l2 * 80 * 2048, tid_g, nthr_g);
                phase_rope(ws, POSITIONS, tid_g, nthr_g);
                if (tid_g < DEPTH * 256) { const int l2 = tid_g >> 8, wh = (tid_g >> 6) & 3, d = tid_g & 63;
                    ((float*)(ws + WS_GN))[tid_g] = ((const float*)args.in[10 + wh])[l2 * 64 + d]; }
            }
            ConvSrc S; S.w_in = (const float*)args.in[3] + (size_t)l * 2048 * DIN; S.w_uq = (const float*)args.in[5] + (size_t)l * 512 * 3072; S.w_ukv = (const float*)args.in[7] + (size_t)l * 512 * 4096;
            S.w_ba = (const float*)args.in[15] + (size_t)l * 2048 * 2048; S.w_bb = (const float*)args.in[16] + (size_t)l * 1024 * 2048; S.w_bc = (const float*)args.in[17] + (size_t)l * 1024 * 2048;
            S.w_out = (const float*)args.in[18] + (size_t)l * 2048 * 2048; S.g_cq = (const float*)args.in[4] + l * 512; S.g_ckv = (const float*)args.in[6] + l * 512;
            S.w_eg = (const float*)args.in[22] + (size_t)l * 64 * 2048 * 512; S.w_eu = (const float*)args.in[23] + (size_t)l * 64 * 2048 * 512; S.w_ed = (const float*)args.in[24] + (size_t)l * 64 * 512 * 2048;
            phase_convert(S, ws, gw, NGW, 7552, lane, lds + 65536 + wave * 9216);
            if (l == 0) xcd_barrier(bar);
            else { asm volatile("s_waitcnt vmcnt(0)" ::: "memory"); __syncthreads(); }
            if (l == 0) phase_norm_skinny<false, false>((const float*)args.in[0], nullptr, nullptr, nullptr, (const float*)args.in[2], (const bf16*)(ws + WS_WSK), XN, (float*)(ws + WS_RS), (float*)(ws + WS_SK), nullptr, nullptr, nullptr, nullptr, lds, gw, NGW, wave, lane, (const float*)args.in[9] + l * 192 + 128, (const float*)(ws + WS_ROPE), (float*)(ws + WS_KNOPE));
            if (l != 0) phase_norm_skinny<true, false, true>(XOB, XBB, YB, (const int*)(ws + WS_ASG) + 3 * NASG, (const float*)args.in[2] + l * DM, (const bf16*)(ws + WS_WSK) + (size_t)l * 80 * 2048, XN, (float*)(ws + WS_RS), (float*)(ws + WS_SK), nullptr, nullptr, nullptr, nullptr, lds, gw, NGW, wave, lane, (const float*)args.in[9] + l * 192 + 128, (const float*)(ws + WS_ROPE), (float*)(ws + WS_KNOPE));
        PH_END
        PH_BEGIN
            phase_cumsum(ws, (const float*)args.in[14] + l * 16, lds, vcu, G, tid, lane);
            { pg8::Gemm g{XN, (const bf16*)(ws + WS_WIN), NTOK, NBIG, DM}; pg8::StaticOrder S; S.init(NTOK, NBIG, G, bx);
              pg8::EpiSeg E{ws, (const float*)(ws + WS_GN) + l * 256};
              pg8::gemm_phase<pg8::EpiSeg, pg8::StaticOrder, true, true>(lds + RING_OFF, g, S, E); }
        PH_END
        PH_BEGIN
            { pg8::Gemm g{CQ, (const bf16*)(ws + WS_WUQ), NTOK, 3072, 512}; pg8::StaticOrder S; S.init(NTOK, 3072, G, bx); pg8::EpiPlain E{QM, 3072};
              pg8::gemm_phase<pg8::EpiPlain, pg8::StaticOrder, true, true>(lds + RING_OFF, g, S, E); }
            { pg8::Gemm g{CKV, (const bf16*)(ws + WS_WUKV), NTOK, 4096, 512}; pg8::StaticOrder S; S.init(NTOK, 4096, G, bx); pg8::EpiKF E{KM, VM, (const float*)(ws + WS_PART), (const float*)(ws + WS_KNOPE), (const float*)(ws + WS_SK), (const float*)args.in[9] + l * 192, (unsigned)(size_t)(lds + RING_BYTES + 2048)};
              pg8::gemm_phase<pg8::EpiKF, pg8::StaticOrder, true, true>(lds + RING_OFF, g, S, E); }
        PH_END
        PH_BEGIN
            { LAS unsigned* slot = (LAS unsigned*)(lds + RING_BYTES + 64);
#define ATT_QUEUE(QI, CALL) for (int dq_ = 0; dq_ < 8; ++dq_) { const int xq_ = (int)((bar.x + (unsigned)dq_) & 7u); \
                gu32* q_ = ctl + CW_AQ + ((l * 3 + (QI)) * 8 + xq_) * 64; \
                if (threadIdx.x == 0) *slot = __hip_atomic_fetch_add(q_, 1u, __ATOMIC_RELAXED, __HIP_MEMORY_SCOPE_AGENT); \
                __syncthreads(); unsigned cur = (unsigned)__builtin_amdgcn_readfirstlane((int)*slot); __syncthreads(); \
                while (cur < 128u) { unsigned nxt_ = 0u; if (threadIdx.x == 0) nxt_ = __hip_atomic_fetch_add(q_, 1u, __ATOMIC_RELAXED, __HIP_MEMORY_SCOPE_AGENT); \
                    const int qb = 15 - (int)((cur & 31u) >> 1), bh = (int)(2u * (cur >> 5) + (cur & 1u)) * 8 + xq_, b = bh >> 4, h = bh & 15; \
                    CALL; \
                    if (threadIdx.x == 0) *slot = nxt_; \
                    __syncthreads(); cur = (unsigned)__builtin_amdgcn_readfirstlane((int)*slot); __syncthreads(); } }
              for (int dq_ = 0; dq_ < 8; ++dq_) { const int xq_ = (int)((bar.x + (unsigned)dq_) & 7u);
                gu32* q_ = ctl + CW_AQ + ((l * 3 + 0) * 8 + xq_) * 64;
                if (threadIdx.x == 0) *slot = __hip_atomic_fetch_add(q_, 1u, __ATOMIC_RELAXED, __HIP_MEMORY_SCOPE_AGENT);
                __syncthreads(); unsigned cur = (unsigned)__builtin_amdgcn_readfirstlane((int)*slot); __syncthreads();
                while (cur < 176u) { unsigned nxt_ = 0u; if (threadIdx.x == 0) nxt_ = __hip_atomic_fetch_add(q_, 1u, __ATOMIC_RELAXED, __HIP_MEMORY_SCOPE_AGENT);
                    const unsigned grp = cur / 11u, pos = cur - grp * 11u;
                    if (pos == 3u || pos == 7u || pos == 10u) {
                        const int chunk = xq_ * 48 + (int)grp * 3 + (pos == 3u ? 0 : (pos == 7u ? 1 : 2));
                        conv_expert_items((const float*)args.in[22] + (size_t)l * 64 * 2048 * 512, (const float*)args.in[23] + (size_t)l * 64 * 2048 * 512, (const float*)args.in[24] + (size_t)l * 64 * 512 * 2048,
                                          (const float*)args.in[15] + (size_t)l * 2048 * 2048, (const float*)args.in[16] + (size_t)l * 1024 * 2048, (const float*)args.in[17] + (size_t)l * 1024 * 2048, (const float*)args.in[18] + (size_t)l * 2048 * 2048,
                                          ws, chunk * 128 + wave, chunk * 8 + wave, lds + 65536 + wave * 9216);
                    } else {
                        const unsigned u = grp * 8u + pos - (pos > 3u ? 1u : 0u) - (pos > 7u ? 1u : 0u);
                        const int qb = 15 - (int)((u & 31u) >> 1), bh = (int)(2u * (u >> 5) + (u & 1u)) * 8 + xq_, b = bh >> 4, h = bh & 15;
                        attn_unit<192, 128, 0>(lds, QM, KM, VM, OA, 3072, 2048, b, h, qb, nullptr, 0.f, (const float*)args.in[8] + l * 192, (const float*)(ws + WS_ROPE));
                    }
                    if (threadIdx.x == 0) *slot = nxt_;
                    __syncthreads(); cur = (unsigned)__builtin_amdgcn_readfirstlane((int)*slot); __syncthreads(); } }
              float fox_bound; { int t2_ = threadIdx.x; asm volatile("" : "+v"(t2_)); const int ln2 = t2_ & 63; const float gq = fabsf(((const float*)args.in[12])[l * 64 + ln2]), gk = fabsf(((const float*)args.in[13])[l * 64 + ln2]); float mq = gq, mk = gk;
#pragma unroll
                for (int o = 1; o < 64; o <<= 1) { mq = fmaxf(mq, bperm_xor(mq, o, ln2)); mk = fmaxf(mk, bperm_xor(mk, o, ln2)); }
                fox_bound = 8.0f * LOG2E * mq * mk * 1.03f; }
              ATT_QUEUE(1, (attn_unit<64, 64, 1>(lds, QKV6 + 3 * SEGS, QKV6 + 4 * SEGS, QKV6 + 5 * SEGS, OC, 1024, 1024, b, h, qb, (const float*)(ws + WS_CUMF), fox_bound)));
              ATT_QUEUE(2, (attn_unit<64, 64, 2>(lds, QKV6, QKV6 + SEGS, QKV6 + 2 * SEGS, OB, 1024, 1024, b, h, qb, nullptr, 0.f)));
#undef ATT_QUEUE
            }
        PH_END
        PH_BEGIN
            { pg8::Gemm g{OA, (const bf16*)(ws + WS_WBA), NTOK, DM, 2048}; pg8::StaticOrder S; S.init(NTOK, DM, G, bx); pg8::EpiMerge<0> E{GATES, MB};
              pg8::gemm_phase<pg8::EpiMerge<0>, pg8::StaticOrder, true, true>(lds + RING_OFF, g, S, E); }
            { pg8::Gemm g{OB, (const bf16*)(ws + WS_WBB), NTOK, DM, 1024}; pg8::StaticOrder S; S.init(NTOK, DM, G, bx); pg8::EpiMerge<1> E{GATES + 2048, MB};
              pg8::gemm_phase<pg8::EpiMerge<1>, pg8::StaticOrder, true, true>(lds + RING_OFF, g, S, E); }
            { pg8::Gemm g{OC, (const bf16*)(ws + WS_WBC), NTOK, DM, 1024}; pg8::StaticOrder S; S.init(NTOK, DM, G, bx); pg8::EpiMerge<2> E{GATES + 4096, MB};
              pg8::gemm_phase<pg8::EpiMerge<2>, pg8::StaticOrder, true, true>(lds + RING_OFF, g, S, E); }
        PH_END
        PH_BEGIN
            { pg8::Gemm g{MB, (const bf16*)(ws + WS_WOUT), NTOK, DM, 2048}; pg8::StaticOrder S; S.init(NTOK, DM, G, bx);
              if (l == 0) { pg8::EpiResidB<false> E{args.in[0], XOB}; pg8::gemm_phase<pg8::EpiResidB<false>, pg8::StaticOrder, true, true>(lds + RING_OFF, g, S, E); }
              else { pg8::EpiResidB<true> E{XBB, XOB}; pg8::gemm_phase<pg8::EpiResidB<true>, pg8::StaticOrder, true, true>(lds + RING_OFF, g, S, E); } }
        PH_END
        PH_BEGIN
            { int* asg_e = (int*)(ws + WS_ASG);
              phase_norm_skinny<false, true, true>(XOB, nullptr, nullptr, nullptr, (const float*)args.in[19] + l * DM, (const bf16*)(ws + WS_WRT) + (size_t)l * 80 * 2048, XN, (float*)(ws + WS_RS2), nullptr,
                                             (unsigned*)(ctl + CW_CNT + 64 * l), asg_e, asg_e + NASG, (float*)(asg_e + 2 * NASG), lds, gw, NGW, wave, lane); }
        PH_END
        PH_BEGIN
            phase_dispatch(ws, XOB, (const float*)args.in[19] + l * DM, (const unsigned*)(ctl + CW_CNT + 64 * l), lds, gw, NGW, tid, lane, bx);
        PH_END
        PH_BEGIN
            { pg8::Gemm g{HS, (const bf16*)(ws + WS_WGU), MAXSLOT, NEXP * 1024, 2048}; pg8::MoeOrder S{(const int*)(ws + WS_TAB), 4, G, bx}; pg8::EpiSwiglu E{ACT, (const float*)(ws + WS_ASG) + 4 * NASG + MAXSLOT};
              pg8::gemm_phase<pg8::EpiSwiglu, pg8::MoeOrder, true, true>(lds + RING_OFF, g, S, E); }
        PH_END
        PH_BEGIN
            { pg8::Gemm g{ACT, (const bf16*)(ws + WS_WD), MAXSLOT, NEXP * 2048, 512}; pg8::MoeOrder S{(const int*)(ws + WS_TAB), 8, G, bx}; pg8::EpiDown E{YB, (const float*)(ws + WS_ASG) + 4 * NASG};
              pg8::gemm_phase<pg8::EpiDown, pg8::MoeOrder, true, true>(lds + RING_OFF, g, S, E); }
        PH_END
    }
    PH_BEGIN
        phase_combine(ws, XOB, XO, gw, NGW, lane);
    PH_END
#undef PH_BEGIN
#undef PH_END
}
constexpr int N_PHASES = 1 + 10 * DEPTH;

extern "C" void kernel_launch(void* const* d_in, const int* in_sizes, int n_in, void* d_out, int out_size, void* d_ws, size_t ws_size, hipStream_t stream) {
    static int grid = 0;
    if (grid == 0) {
        if (n_in != 25 || out_size != NTOK * DM || ws_size < WS_END) { fprintf(stderr, "kernel_launch: unexpected shapes (n_in %d out %d ws %zu need %zu); nothing launched\n", n_in, out_size, ws_size, (size_t)WS_END); grid = -1; return; }
        int dev = 0, cus = 0, per_cu = 0;
        if (hipGetDevice(&dev) != hipSuccess || hipDeviceGetAttribute(&cus, hipDeviceAttributeMultiprocessorCount, dev) != hipSuccess) { grid = -1; return; }
        if (hipFuncSetAttribute((const void*)mk_fwd, hipFuncAttributeMaxDynamicSharedMemorySize, LDS_BYTES) != hipSuccess) { fprintf(stderr, "kernel_launch: hipFuncSetAttribute failed\n"); grid = -1; return; }
        if (hipOccupancyMaxActiveBlocksPerMultiprocessor(&per_cu, (const void*)mk_fwd, NWAVES * 64, LDS_BYTES) != hipSuccess || per_cu < 1) { fprintf(stderr, "kernel_launch: occupancy query says %d blocks per CU\n", per_cu); }
        (void)hipGetLastError();
        grid = cus;
    }
    if (grid < 0) return;
    if (hipMemsetAsync((char*)d_ws + WS_CTL, 0, CTL_ZERO_BYTES, stream) != hipSuccess) { fprintf(stderr, "kernel_launch: memset failed\n"); return; }
    Args a{};
    for (int i = 0; i < 25; ++i) a.in[i] = d_in[i];
    a.out = (float*)d_out; a.ws = (unsigned char*)d_ws; a.ph_lo = 0; a.ph_hi = N_PHASES;
    hipLaunchKernelGGL(mk_fwd, dim3(grid), dim3(NWAVES * 64), LDS_BYTES, stream, a);
    const hipError_t le = hipPeekAtLastError();
    if (le != hipSuccess) fprintf(stderr, "kernel_launch: launch failed: %s\n", hipGetErrorName(le));
}
```
